# Optimizing an MI355X kernel written in HIP

```python
import jax, jax.numpy as jnp
from jax import lax
import numpy as np

D_MODEL = 1024
BATCH = 16
SEQ = 256
DEPTH = 1
DEC_BATCH = 2
DEC_SEQ = 4096
PAST_LEN = 512

GRID_W = 64
ML_HEADS = 4
ML_DIM = 1024
ML_HEAD_DIM = ML_DIM // ML_HEADS
SC_DIM = 1024
CONV_W = 3
D_FF = 2816
CHUNK = 128
N_MOD = 9
N_DIR = 2
EPS = 1e-6

Q_OFF = 0
K_OFF = Q_OFF + ML_DIM
V_OFF = K_OFF + ML_DIM
O_OFF = V_OFF + ML_DIM
IG_OFF = O_OFF + ML_DIM
FG_OFF = IG_OFF + N_DIR * ML_HEADS
B_OFF = FG_OFF + N_DIR * ML_HEADS
C_OFF = B_OFF + SC_DIM
X_OFF = C_OFF + SC_DIM
GML_OFF = X_OFF + SC_DIM
GSC_OFF = GML_OFF + D_MODEL
IN_COLS = GSC_OFF + D_MODEL

kernel_name = "hybrid_mlstm_shortconv_diffusion_step"


def rmsnorm(x, g):
    x32 = x.astype(jnp.float32)
    y = x32 * lax.rsqrt(jnp.mean(x32 * x32, axis=-1, keepdims=True) + EPS)
    return (y * g.astype(jnp.float32)).astype(x.dtype)


def modulate(h, shift, scale):
    return h * (1.0 + scale[:, None, :]) + shift[:, None, :]


def swiglu(h, w1, w2):
    a, b = jnp.split(h @ w1, 2, axis=-1)
    return (jax.nn.silu(a) * b) @ w2


def conv3_centred(u, w, b):
    up = jnp.pad(u, [(0, 0)] * (u.ndim - 2) + [(1, 1), (0, 0)])
    return up[..., :-2, :] * w[0] + up[..., 1:-1, :] * w[1] + up[..., 2:, :] * w[2] + b


def mlstm_chunkwise(q, k, v, i_pre, f_pre, C0, n0, m0):
    f32 = jnp.float32
    bsz, nh, t_len, dh = q.shape
    nc = t_len // CHUNK

    def chunks(t):
        t = t.astype(f32).reshape((bsz, nh, nc, CHUNK) + t.shape[3:])
        return jnp.moveaxis(t, 2, 0)

    xs = (chunks(q), chunks(k), chunks(v), chunks(i_pre),
          chunks(jax.nn.log_sigmoid(f_pre.astype(f32))))
    causal = jnp.tril(jnp.ones((CHUNK, CHUNK), dtype=bool))

    def step(carry, inp):
        C, n, m = carry
        qc, kc, vc, ic, lfc = inp
        b = jnp.cumsum(lfc, axis=-1)
        a = b + m[..., None]
        dmat = jnp.where(causal, b[..., :, None] - b[..., None, :] + ic[..., None, :], -jnp.inf)
        m_t = jnp.maximum(a, jnp.max(dmat, axis=-1))
        w_intra = jnp.exp(dmat - m_t[..., None])
        w_inter = jnp.exp(a - m_t)
        s = jnp.einsum('bhtd,bhsd->bhts', qc, kc) * w_intra
        num = (jnp.einsum('bhts,bhse->bhte', s, vc)
               + w_inter[..., None] * jnp.einsum('bhtd,bhde->bhte', qc, C))
        den = jnp.sum(s, axis=-1) + w_inter * jnp.einsum('bhtd,bhd->bht', qc, n)
        h = num / jnp.maximum(jnp.abs(den), jnp.exp(-m_t))[..., None]
        bl = b[..., -1]
        g = bl[..., None] - b + ic
        m_new = jnp.maximum(bl + m, jnp.max(g, axis=-1))
        decay = jnp.exp(bl + m - m_new)
        wk = jnp.exp(g - m_new[..., None])
        C_new = decay[..., None, None] * C + jnp.einsum('bhs,bhsd,bhse->bhde', wk, kc, vc)
        n_new = decay[..., None] * n + jnp.einsum('bhs,bhsd->bhd', wk, kc)
        return (C_new, n_new, m_new), h

    carry0 = (C0.astype(f32), n0.astype(f32), m0.astype(f32))
    (C, n, m), h = lax.scan(step, carry0, xs)
    h = jnp.moveaxis(h, 0, 2).reshape(bsz, nh, t_len, dh)
    return h, C, n, m


def mlstm_bidir(q, k, v, ig, fg, C0, n0, m0):
    hf, Cf, nf, mf = mlstm_chunkwise(q, k, v, ig[:, 0], fg[:, 0], C0[:, 0], n0[:, 0], m0[:, 0])
    rq, rk, rv = jnp.flip(q, axis=2), jnp.flip(k, axis=2), jnp.flip(v, axis=2)
    hb, Cb, nb, mb = mlstm_chunkwise(rq, rk, rv, jnp.flip(ig[:, 1], axis=-1),
                                     jnp.flip(fg[:, 1], axis=-1), C0[:, 1], n0[:, 1], m0[:, 1])
    h = hf + jnp.flip(hb, axis=2)
    return h, jnp.stack([Cf, Cb], axis=1), jnp.stack([nf, nb], axis=1), jnp.stack([mf, mb], axis=1)


def mixer(h, C0, n0, m0, rows, w_in, b_in, conv_w, conv_b, ml_norm, w_ml_out, w_sc_out, w_o):
    bsz, t_len, _ = h.shape
    z = h @ w_in + b_in

    def heads(t):
        return t.reshape(bsz, t_len, ML_HEADS, ML_HEAD_DIM).transpose(0, 2, 1, 3)

    q = heads(z[..., Q_OFF:K_OFF])
    k = heads(z[..., K_OFF:V_OFF]) * (ML_HEAD_DIM ** -0.5)
    v = heads(z[..., V_OFF:O_OFF])
    o = jax.nn.sigmoid(z[..., O_OFF:IG_OFF])
    ig = z[..., IG_OFF:FG_OFF].reshape(bsz, t_len, N_DIR, ML_HEADS).transpose(0, 2, 3, 1)
    fg = z[..., FG_OFF:B_OFF].reshape(bsz, t_len, N_DIR, ML_HEADS).transpose(0, 2, 3, 1)
    hm, C, n, m = mlstm_bidir(q, k, v, ig, fg, C0, n0, m0)
    hm = hm * lax.rsqrt(jnp.mean(hm * hm, axis=-1, keepdims=True) + EPS)
    hm = hm.transpose(0, 2, 1, 3).reshape(bsz, t_len, ML_DIM) * ml_norm
    ml = (o * hm) @ w_ml_out

    bg = z[..., B_OFF:C_OFF]
    cg = z[..., C_OFF:X_OFF]
    xs = z[..., X_OFF:GML_OFF]
    u = cg * xs
    if rows is None:
        uc = conv3_centred(u, conv_w, conv_b)
    else:
        uc = conv3_centred(u.reshape(bsz, rows, GRID_W, SC_DIM), conv_w, conv_b)
        uc = uc.reshape(bsz, t_len, SC_DIM)
    sc = (bg * uc) @ w_sc_out

    y = jax.nn.sigmoid(z[..., GML_OFF:GSC_OFF]) * ml + jax.nn.sigmoid(z[..., GSC_OFF:IN_COLS]) * sc
    return y @ w_o, C, n, m


def trunk_layer(x, cond, C0, n0, m0, rows, w_mod, b_mod, norm_g, ffn1_w1, ffn1_w2, w_in, b_in,
                conv_w, conv_b, ml_norm, w_ml_out, w_sc_out, w_o, ffn2_w1, ffn2_w2):
    mod = jax.nn.silu(cond) @ w_mod + b_mod
    sh1, sc1, g1, shm, scm, gm, sh2, sc2, g2 = jnp.split(mod, N_MOD, axis=-1)
    h = modulate(rmsnorm(x, norm_g[0]), sh1, sc1)
    x = x + 0.5 * g1[:, None, :] * swiglu(h, ffn1_w1, ffn1_w2)
    h = modulate(rmsnorm(x, norm_g[1]), shm, scm)
    y, C, n, m = mixer(h, C0, n0, m0, rows, w_in, b_in, conv_w, conv_b, ml_norm,
                       w_ml_out, w_sc_out, w_o)
    x = x + gm[:, None, :] * y
    h = modulate(rmsnorm(x, norm_g[2]), sh2, sc2)
    x = x + 0.5 * g2[:, None, :] * swiglu(h, ffn2_w1, ffn2_w2)
    return x, C, n, m


def setup_inputs(seed: int = 0) -> dict:
    key = jax.random.key(seed)
    ks = jax.random.split(key, 24)
    f32 = jnp.float32
    D = D_MODEL

    def nrm(k, shape, s):
        return jax.random.normal(k, shape, f32) * s

    fbias = jnp.tile(jnp.linspace(3.0, 6.0, ML_HEADS, dtype=f32), N_DIR)
    return {
        'x_prompt': nrm(ks[0], (BATCH, SEQ, D), 1.0),
        'x_sample': nrm(ks[1], (DEC_BATCH, DEC_SEQ, D), 1.0),
        'state_C': nrm(ks[2], (DEC_BATCH, DEPTH, N_DIR, ML_HEADS, ML_HEAD_DIM, ML_HEAD_DIM), 0.5),
        'state_n': nrm(ks[3], (DEC_BATCH, DEPTH, N_DIR, ML_HEADS, ML_HEAD_DIM), 0.5),
        'state_m': nrm(ks[4], (DEC_BATCH, DEPTH, N_DIR, ML_HEADS), 1.0),
        'c': nrm(ks[5], (DEC_BATCH, D), 1.0),
        'c_ctx': nrm(ks[6], (D,), 1.0),
        'w_mod': nrm(ks[7], (DEPTH, D, N_MOD * D), 0.5 * D ** -0.5),
        'b_mod': nrm(ks[8], (DEPTH, N_MOD * D), 0.02),
        'norm_g': 1.0 + nrm(ks[9], (DEPTH, 3, D), 0.02),
        'ffn1_w1': nrm(ks[10], (DEPTH, D, 2 * D_FF), D ** -0.5),
        'ffn1_w2': nrm(ks[11], (DEPTH, D_FF, D), D_FF ** -0.5),
        'w_in': nrm(ks[12], (DEPTH, D, IN_COLS), D ** -0.5),
        'b_in': nrm(ks[13], (DEPTH, IN_COLS), 0.02).at[:, FG_OFF:B_OFF].add(fbias),
        'conv_w': nrm(ks[14], (DEPTH, CONV_W, SC_DIM), CONV_W ** -0.5),
        'conv_b': nrm(ks[15], (DEPTH, SC_DIM), 0.02),
        'ml_norm': 1.0 + nrm(ks[16], (DEPTH, ML_DIM), 0.02),
        'w_ml_out': nrm(ks[17], (DEPTH, ML_DIM, D), ML_DIM ** -0.5),
        'w_sc_out': nrm(ks[18], (DEPTH, SC_DIM, D), SC_DIM ** -0.5),
        'w_o': nrm(ks[19], (DEPTH, D, D), D ** -0.5),
        'ffn2_w1': nrm(ks[20], (DEPTH, D, 2 * D_FF), D ** -0.5),
        'ffn2_w2': nrm(ks[21], (DEPTH, D_FF, D), D_FF ** -0.5),
        'final_norm': 1.0 + nrm(ks[22], (D,), 0.02),
    }


def reference(x_prompt, x_sample, state_C, state_n, state_m, c, c_ctx, w_mod, b_mod, norm_g,
              ffn1_w1, ffn1_w2, w_in, b_in, conv_w, conv_b, ml_norm, w_ml_out, w_sc_out, w_o,
              ffn2_w1, ffn2_w2, final_norm):
    f32 = jnp.float32
    bp = x_prompt.shape[0]
    rows = x_sample.shape[1] // GRID_W
    zC = jnp.zeros((bp, N_DIR, ML_HEADS, ML_HEAD_DIM, ML_HEAD_DIM), f32)
    zn = jnp.zeros((bp, N_DIR, ML_HEADS, ML_HEAD_DIM), f32)
    zm = jnp.zeros((bp, N_DIR, ML_HEADS), f32)
    xp, xs = x_prompt, x_sample
    Cs, ns, ms = [], [], []
    for l in range(DEPTH):
        lw = (w_mod[l], b_mod[l], norm_g[l], ffn1_w1[l], ffn1_w2[l], w_in[l], b_in[l],
              conv_w[l], conv_b[l], ml_norm[l], w_ml_out[l], w_sc_out[l], w_o[l],
              ffn2_w1[l], ffn2_w2[l])
        xp, Cl, nl, ml_ = trunk_layer(xp, c_ctx[None, :], zC, zn, zm, None, *lw)
        Cs.append(Cl)
        ns.append(nl)
        ms.append(ml_)
        xs, _, _, _ = trunk_layer(xs, c, state_C[:, l], state_n[:, l], state_m[:, l], rows, *lw)
    y_prompt = rmsnorm(xp, final_norm)
    y_sample = rmsnorm(xs, final_norm)
    new_state_C = jnp.stack(Cs, axis=1)
    new_state_n = jnp.stack(ns, axis=1)
    new_state_m = jnp.stack(ms, axis=1)
    return (y_prompt, y_sample, new_state_C, new_state_n, new_state_m)
```

```cpp
#include <hip/hip_runtime.h>
#include <hip/hip_cooperative_groups.h>
#include <cstdio>
namespace cg = cooperative_groups;
namespace pg8 {
#define PG8_LAS __attribute__((address_space(3)))
typedef unsigned short bf16_t;
typedef short bf16x8 __attribute__((ext_vector_type(8)));
typedef float f32x4 __attribute__((ext_vector_type(4)));
typedef unsigned u32x4 __attribute__((ext_vector_type(4)));
constexpr int BM = 256, BK = 64, HALF = 128, HTB = HALF * BK * 2  , STAGE_BYTES = 8 * HTB, NXCD = 8, WGM = 8;

__host__ __device__ __forceinline__ int lds_byte(int r, int c) { const int st = (r >> 4) * 2 + (c >> 5), rr = r & 15, cc = c & 31, ob = rr * 64 + cc * 2; return st * 1024 + (ob ^ (((ob >> 9) & 1) << 5)); }
__host__ __device__ __forceinline__ void stage_rc(int b, int& R, int& C) { const int st = b / 1024, sb = b % 1024, swz = sb ^ (((sb >> 9) & 1) << 5); R = (st >> 1) * 16 + swz / 64; C = (st & 1) * 32 + (swz % 64) / 2; }
__host__ __device__ __forceinline__ int perm32(int rho) { const int n = rho >> 4, i = rho & 15; return 8 * (i >> 2) + 4 * n + (i & 3); }

struct Unit { int pm, pn; };
struct Gemm { const bf16_t* A; const bf16_t* Bt; int M, N, K; };
struct StaticOrder {
    int nM, nN, nwg, G, c;
    __host__ __device__ void init(int M, int N, int G_, int c_) { nM = M / BM; nN = N / BM; nwg = nM * nN; G = G_; c = c_; }
    __host__ __device__ bool next(int i, Unit& u) const {
        const long L = (long)i * G + c; if (L >= nwg) return false;
        int wgid = (int)L; { const int q = nwg / NXCD, r = nwg % NXCD, xcd = wgid % NXCD, off = wgid / NXCD; wgid = (xcd < r ? xcd * (q + 1) : r * (q + 1) + (xcd - r) * q) + off; }
        const int nig = WGM * nN, gid = wgid / nig, fm = gid * WGM, gsz = (nM - fm) < WGM ? (nM - fm) : WGM;
        u.pm = fm + ((wgid % nig) % gsz); u.pn = (wgid % nig) / gsz; return true;
    }
    __device__ __forceinline__ void a_ready(const Unit&) const {}
    __device__ __forceinline__ void done(const Unit&) const {}
};
__device__ __forceinline__ unsigned cvt_pk_bf16(float lo, float hi) { unsigned r; asm volatile("v_cvt_pk_bf16_f32 %0, %1, %2" : "=v"(r) : "v"(lo), "v"(hi)); return r; }
template <class Epi, class Sched, bool STAMP = false>
__device__ __forceinline__ void gemm_phase(PG8_LAS unsigned char* lds, const Gemm g, const Sched& S, const Epi& E, unsigned long long* stamps) {
    const int tid = threadIdx.x, wid = __builtin_amdgcn_readfirstlane(tid >> 6), lane = tid & 63, wr = wid >> 2, wc = wid & 3, fr = lane & 15, fq = lane >> 4;
    const int K = g.K, nt = K / BK;
    int ts_lo = 0, ts_hi = 0, nts = 0; const unsigned long long rt_entry = STAMP ? (unsigned long long)wall_clock64() : 0ull;
#define PG8_STAMP() do { if (STAMP && wid == 0 && nts < 64) { const unsigned long long _c = (unsigned long long)clock64(); \
        ts_lo = (lane == nts) ? (int)(unsigned)_c : ts_lo; ts_hi = (lane == nts) ? (int)(unsigned)(_c >> 32) : ts_hi; ++nts; } } while (0)
    PG8_STAMP();
    unsigned voffA[2], voffB[2];
#pragma unroll
    for (int i = 0; i < 2; ++i) { int R, C; stage_rc(tid * 16 + i * 8192, R, C); const int Rb = Epi::PERM ? ((R & ~31) + perm32(R & 31)) : R;
        voffA[i] = (unsigned)(R * K + C) * 2u; voffB[i] = (unsigned)(Rb * K + C) * 2u; }
    const size_t kstep = (size_t)(BK * 2);
    const size_t hstep = (size_t)HALF * K * 2;
    const size_t tstep = 2 * hstep;
    const unsigned ldsw = (unsigned)wid * 1024u;
    const int aoff = lds_byte(wr * 64 + fr, fq * 8), boff = lds_byte(wc * 32 + fr, fq * 8);
#define PG8_SA(b, h) (((b) * 2 + (h)) * HTB)
#define PG8_SB(b, h) ((4 + (b) * 2 + (h)) * HTB)
#define PG8_STAGE(bufoff, gbase, voff) do { _Pragma("unroll") for (int _i = 0; _i < 2; ++_i) \
        __builtin_amdgcn_global_load_lds((const unsigned*)((const char*)(gbase) + (voff)[_i]), (PG8_LAS unsigned*)(lds + (bufoff) + ldsw + _i * 8192), 16, 0, 0); } while (0)
#define PG8_LDA(dst, b, h) do { _Pragma("unroll") for (int m = 0; m < 4; ++m) _Pragma("unroll") for (int k = 0; k < 2; ++k) dst[m][k] = *(const PG8_LAS bf16x8*)(lds + PG8_SA(b, h) + aoff + m * 2048 + k * 1024); } while (0)
#define PG8_LDB(dst, b, h) do { _Pragma("unroll") for (int n = 0; n < 2; ++n) _Pragma("unroll") for (int k = 0; k < 2; ++k) dst[n][k] = *(const PG8_LAS bf16x8*)(lds + PG8_SB(b, h) + boff + n * 2048 + k * 1024); } while (0)
#define PG8_MMA(ai, bj, At, Bt) do { __builtin_amdgcn_s_setprio(1); _Pragma("unroll") for (int m = 0; m < 4; ++m) _Pragma("unroll") for (int n = 0; n < 2; ++n) _Pragma("unroll") for (int k = 0; k < 2; ++k) \
        acc[ai][bj][m][n] = __builtin_amdgcn_mfma_f32_16x16x32_bf16(Bt[n][k], At[m][k], acc[ai][bj][m][n], 0, 0, 0); __builtin_amdgcn_s_setprio(0); } while (0)
#define PG8_WAIT_V(n) asm volatile("s_waitcnt vmcnt(" #n ")" ::: "memory")
#define PG8_WAIT_L(n) asm volatile("s_waitcnt lgkmcnt(" #n ")" ::: "memory")
#define PG8_BAR __builtin_amdgcn_s_barrier()
#define PG8_SCHED __builtin_amdgcn_sched_barrier(0)
    Unit cur, nxt; int ui = 0;
    if (!S.next(0, cur)) return;
    f32x4 acc[2][2][4][2];
#pragma unroll
    for (int a = 0; a < 2; ++a)
#pragma unroll
        for (int b = 0; b < 2; ++b)
#pragma unroll
            for (int m = 0; m < 4; ++m)
#pragma unroll
                for (int n = 0; n < 2; ++n) acc[a][b][m][n] = (f32x4){0.f, 0.f, 0.f, 0.f};
    bf16x8 At[4][2], B0[2][2], B1[2][2];
    const char* cA = (const char*)g.A + (size_t)cur.pm * tstep; const char* cB = (const char*)g.Bt + (size_t)cur.pn * tstep;
    S.a_ready(cur);
    PG8_STAGE(PG8_SB(0, 0), cB, voffB); PG8_STAGE(PG8_SA(0, 0), cA, voffA); PG8_STAGE(PG8_SB(0, 1), cB + hstep, voffB); PG8_STAGE(PG8_SA(0, 1), cA + hstep, voffA);
    if (wr == 1) PG8_BAR;
    PG8_WAIT_V(4); PG8_BAR;
    PG8_STAGE(PG8_SB(1, 0), cB + kstep, voffB); PG8_STAGE(PG8_SA(1, 0), cA + kstep, voffA); PG8_STAGE(PG8_SB(1, 1), cB + hstep + kstep, voffB);
    PG8_WAIT_V(6); PG8_BAR;
    PG8_STAMP();
    for (;;) {
        const bool has_next = S.next(ui + 1, nxt);
        const char* nA = has_next ? (const char*)g.A + (size_t)nxt.pm * tstep : cA; const char* nB = has_next ? (const char*)g.Bt + (size_t)nxt.pn * tstep : cB;
        for (int t = 0; t < nt; t += 2) {
            const bool last = (t == nt - 2);
            const char* a1 = cA + (size_t)(t + 1) * kstep;
            const char* a2 = last ? nA : cA + (size_t)(t + 2) * kstep; const char* b2 = last ? nB : cB + (size_t)(t + 2) * kstep;
            const char* a3 = a2 + kstep; const char* b3 = b2 + kstep;
            if (last && has_next) S.a_ready(nxt);
            PG8_LDB(B0, 0, 0); PG8_SCHED; PG8_LDA(At, 0, 0); PG8_STAGE(PG8_SA(1, 1), a1 + hstep, voffA);
            PG8_WAIT_L(8); PG8_BAR; PG8_WAIT_L(0); PG8_MMA(0, 0, At, B0); PG8_BAR; PG8_SCHED;
            PG8_LDB(B1, 0, 1); PG8_STAGE(PG8_SB(0, 0), b2, voffB);
            PG8_BAR; PG8_WAIT_L(0); PG8_MMA(0, 1, At, B1); PG8_BAR;
            PG8_LDA(At, 0, 1); PG8_STAGE(PG8_SA(0, 0), a2, voffA);
            PG8_BAR; PG8_WAIT_L(0); PG8_MMA(1, 0, At, B0); PG8_BAR; PG8_SCHED;
            PG8_STAGE(PG8_SB(0, 1), b2 + hstep, voffB);
            PG8_WAIT_V(6); PG8_BAR; PG8_MMA(1, 1, At, B1); PG8_BAR;
            PG8_LDB(B0, 1, 0); PG8_SCHED; PG8_LDA(At, 1, 0); PG8_STAGE(PG8_SA(0, 1), a2 + hstep, voffA);
            PG8_WAIT_L(8); PG8_BAR; PG8_WAIT_L(0); PG8_MMA(0, 0, At, B0); PG8_BAR; PG8_SCHED;
            PG8_LDB(B1, 1, 1); PG8_STAGE(PG8_SB(1, 0), b3, voffB);
            PG8_BAR; PG8_WAIT_L(0); PG8_MMA(0, 1, At, B1); PG8_BAR;
            PG8_LDA(At, 1, 1); PG8_STAGE(PG8_SA(1, 0), a3, voffA);
            PG8_BAR; PG8_WAIT_L(0); PG8_MMA(1, 0, At, B0); PG8_BAR; PG8_SCHED;
            PG8_STAGE(PG8_SB(1, 1), b3 + hstep, voffB);
            PG8_WAIT_V(6); PG8_BAR; PG8_MMA(1, 1, At, B1); PG8_BAR;
        }
        PG8_STAMP();
        if constexpr (!Epi::AFTER_DRAIN) { E(acc, cur, wr, wc, fr, fq); S.done(cur); }
        PG8_STAMP();
        if (!has_next) break;
#pragma unroll
        for (int a = 0; a < 2; ++a)
#pragma unroll
            for (int b = 0; b < 2; ++b)
#pragma unroll
                for (int m = 0; m < 4; ++m)
#pragma unroll
                    for (int n = 0; n < 2; ++n) acc[a][b][m][n] = (f32x4){0.f, 0.f, 0.f, 0.f};
        cur = nxt; cA = nA; cB = nB; ++ui;
    }
    PG8_WAIT_V(0);
    if (wr == 0) PG8_BAR;
    PG8_BAR;
    if constexpr (Epi::AFTER_DRAIN) { E.fused(acc, cur, wr, wc, fr, fq, lds, wid, lane); S.done(cur); }
    PG8_STAMP();
    if (STAMP && wid == 0) { stamps[lane] = lane < nts ? (((unsigned long long)(unsigned)ts_hi << 32) | (unsigned)ts_lo) : 0ull;
        if (lane == 62) stamps[62] = rt_entry; if (lane == 63) stamps[63] = (unsigned long long)wall_clock64(); }
#undef PG8_STAMP
#undef PG8_SA
#undef PG8_SB
#undef PG8_STAGE
#undef PG8_LDA
#undef PG8_LDB
#undef PG8_MMA
#undef PG8_WAIT_V
#undef PG8_WAIT_L
#undef PG8_BAR
#undef PG8_SCHED
}
}
using pg8::bf16_t; using pg8::bf16x8; using pg8::f32x4; using pg8::u32x4; using pg8::cvt_pk_bf16; using pg8::Unit;
typedef unsigned u32x2 __attribute__((ext_vector_type(2)));
#define DEVI __device__ __forceinline__
#define LAS __attribute__((address_space(3)))

#ifndef COOP
#define COOP 0
#endif

constexpr int NTOK = 12288, NPR = 4096;
constexpr size_t MiB = (size_t)1 << 20, KiB = 1024;
constexpr size_t OFF_W1T = 0, OFF_W2T = 11 * MiB, OFF_WIN = 16 * MiB + 512 * KiB, OFF_CIN = 0;
constexpr size_t OFF_WML = 34 * MiB + 512 * KiB, OFF_WSC = OFF_WML + 2 * MiB, OFF_WO = OFF_WSC + 2 * MiB;
constexpr size_t OFF_MOD = 40 * MiB + 512 * KiB, OFF_BINP = OFF_MOD + 112 * KiB, OFF_GATES = OFF_BINP + 40 * KiB;
constexpr size_t OFF_BQ = OFF_GATES + 768 * KiB, OFF_GI = OFF_BQ + 384 * KiB, OFF_PMX = OFF_GI + 384 * KiB;
constexpr size_t OFF_BL = OFF_PMX + 384 * KiB, OFF_MLOC = OFF_BL + 4 * KiB, OFF_DN = OFF_MLOC + 4 * KiB;
constexpr size_t OFF_Z = 44 * MiB, TB = 24 * MiB;
constexpr int LDS_BYTES = 161792;

struct Params {
    const float *x_prompt, *x_sample, *state_C, *state_n, *state_m, *c, *c_ctx, *w_mod, *b_mod, *norm_g, *ffn1_w1, *ffn1_w2, *w_in, *b_in,
        *conv_w, *conv_b, *ml_norm, *w_ml_out, *w_sc_out, *w_o, *ffn2_w1, *ffn2_w2, *final_norm;
    float* out; unsigned char* ws; int phase_lo, phase_hi;
};

DEVI float bf2f(unsigned short b) { return __uint_as_float(((unsigned)b) << 16); }
DEVI float bf_lo(unsigned u) { return __uint_as_float(u << 16); }
DEVI float bf_hi(unsigned u) { return __uint_as_float(u & 0xffff0000u); }
DEVI unsigned short f2bf(float f) { return (unsigned short)(cvt_pk_bf16(f, f) & 0xffffu); }
DEVI float sigm(float x) { return 1.f / (1.f + __expf(-x)); }
DEVI float silu(float x) { return x / (1.f + __expf(-x)); }
DEVI int cond_of_row(int row) { return row < NPR ? 0 : 1 + ((row - NPR) >> 12); }
DEVI bf16_t* zbuf(const Params& p, int i) { return (bf16_t*)(p.ws + OFF_Z + (size_t)i * TB); }
DEVI float wave_sum(float v) { v += __shfl_xor(v, 32); v += __shfl_xor(v, 16); v += __shfl_xor(v, 8); v += __shfl_xor(v, 4); v += __shfl_xor(v, 2); v += __shfl_xor(v, 1); return v; }

DEVI int win_src_col(int L) {
    if (L < 4096) return L;
    if (L < 5120) return 4112 + (L - 4096);
    if (L < 7168) { const int o = L - 5120, j = o >> 8, w = o & 255; return (w < 128) ? (5136 + 128 * j + w) : (6160 + 128 * j + (w - 128)); }
    if (L < 8192) return 7184 + (L - 7168);
    return 8208 + (L - 8192);
}
DEVI int w1_src_col(int L) { const int j = L >> 8, w = L & 255; return (w < 128) ? (128 * j + w) : (2816 + 128 * j + (w - 128)); }

DEVI void conv_tile(const float* __restrict__ src, int ldsrc, int col0, bf16_t* __restrict__ dst, int Ktot, int L0, int k0, unsigned char* shm) {
    unsigned short* T = (unsigned short*)shm;
    const int t = threadIdx.x, nq = t & 15, kr = t >> 4;
#pragma unroll
    for (int ps = 0; ps < 8; ++ps) { const int k = ps * 32 + kr; const float4 v = *(const float4*)(src + (size_t)(k0 + k) * ldsrc + col0 + 4 * nq);
        T[(4 * nq + 0) * 258 + k] = f2bf(v.x); T[(4 * nq + 1) * 258 + k] = f2bf(v.y); T[(4 * nq + 2) * 258 + k] = f2bf(v.z); T[(4 * nq + 3) * 258 + k] = f2bf(v.w); }
    __syncthreads();
#pragma unroll
    for (int ps = 0; ps < 4; ++ps) { const int n = ps * 16 + (t >> 5), k8 = (t & 31) * 8; const unsigned* s = (const unsigned*)(T + n * 258 + k8);
        u32x4 w; w.x = s[0]; w.y = s[1]; w.z = s[2]; w.w = s[3]; *(u32x4*)(dst + (size_t)(L0 + n) * Ktot + k0 + k8) = w; }
    __syncthreads();
}
DEVI void conv_ffn(const float* w1, const float* w2, const Params& p, int it, unsigned char* shm) {
    if (it < 352) { const int nb = it >> 2, kb = it & 3; conv_tile(w1, 5632, w1_src_col(64 * nb), (bf16_t*)(p.ws + OFF_W1T), 1024, 64 * nb, 256 * kb, shm); }
    else { const int i2 = it - 352, nb = i2 / 11, kb = i2 % 11; conv_tile(w2, 1024, 64 * nb, (bf16_t*)(p.ws + OFF_W2T), 2816, 64 * nb, 256 * kb, shm); }
}
DEVI void phase0(const Params& p, unsigned char* shm) {
    const int t = threadIdx.x;
    float* mod = (float*)(p.ws + OFF_MOD);
    {
        float* sc = (float*)shm; float* red = sc + 3072;
        for (int i = t; i < 3072; i += 512) { const int b = i >> 10, k = i & 1023; const float v = (b == 0) ? p.c_ctx[k] : p.c[(b - 1) * 1024 + k]; sc[i] = silu(v); }
        __syncthreads();
        for (int it = blockIdx.x; it < 144; it += gridDim.x) {
            const int n0 = it * 64, nq = t & 15, kg = t >> 4;
            f32x4 a0 = {0.f, 0.f, 0.f, 0.f}, a1 = a0, a2 = a0;
#pragma unroll 8
            for (int kk = 0; kk < 32; ++kk) { const int k = kg * 32 + kk; const f32x4 w = *(const f32x4*)(p.w_mod + (size_t)k * 9216 + n0 + 4 * nq);
                a0 += sc[k] * w; a1 += sc[1024 + k] * w; a2 += sc[2048 + k] * w; }
            *(f32x4*)(red + (kg * 3 + 0) * 64 + 4 * nq) = a0; *(f32x4*)(red + (kg * 3 + 1) * 64 + 4 * nq) = a1; *(f32x4*)(red + (kg * 3 + 2) * 64 + 4 * nq) = a2;
            __syncthreads();
            if (t < 192) { const int b = t >> 6, n = t & 63; float s = 0.f;
#pragma unroll
                for (int g = 0; g < 32; ++g) s += red[(g * 3 + b) * 64 + n];
                mod[b * 9216 + n0 + n] = s + p.b_mod[n0 + n]; }
            __syncthreads();
        }
    }
    {
        float* binp = (float*)(p.ws + OFF_BINP);
        for (int i = blockIdx.x * 512 + t; i < 9216; i += gridDim.x * 512) binp[i] = p.b_in[win_src_col(i)];
    }
    for (int it = blockIdx.x; it < 1296; it += gridDim.x) {
        if (it < 528) conv_ffn(p.ffn1_w1, p.ffn1_w2, p, it, shm);
        else if (it < 1104) { const int i2 = it - 528, nb = i2 >> 2, kb = i2 & 3; conv_tile(p.w_in, 9232, win_src_col(64 * nb), (bf16_t*)(p.ws + OFF_WIN), 1024, 64 * nb, 256 * kb, shm); }
        else { const int i2 = it - 1104, mtx = i2 >> 6, i3 = i2 & 63, nb = i3 >> 2, kb = i3 & 3;
            const float* src = mtx == 0 ? p.w_ml_out : (mtx == 1 ? p.w_sc_out : p.w_o);
            bf16_t* dst = (bf16_t*)(p.ws + (mtx == 0 ? OFF_WML : (mtx == 1 ? OFF_WSC : OFF_WO)));
            conv_tile(src, 1024, 64 * nb, dst, 1024, 64 * nb, 256 * kb, shm); }
    }
}

template <int MODE> DEVI void row_phase(const Params& p, unsigned char* shm) {
    const int t = threadIdx.x, wid = t >> 6, lane = t & 63;
    const float* mod = (const float*)(p.ws + OFF_MOD);
    float* WgT = (float*)shm;
    if (MODE == 1) {
        for (int i = t; i < 16384; i += 512) { const int k = i >> 4, g = i & 15; WgT[g * 1024 + k] = p.w_in[(size_t)k * 9232 + 4096 + g]; }
        __syncthreads();
    }
    const float* gvec = MODE == 3 ? p.final_norm : p.norm_g + MODE * 1024;
    bf16_t* hout = MODE == 2 ? zbuf(p, 7) : (bf16_t*)(p.out + (size_t)NTOK * 1024);
    float* gates = (float*)(p.ws + OFF_GATES);
    f32x4 gv[4];
#pragma unroll
    for (int i = 0; i < 4; ++i) gv[i] = *(const f32x4*)(gvec + i * 256 + 4 * lane);
    for (int row = blockIdx.x * 8 + wid; row < NTOK; row += gridDim.x * 8) {
        const float* src = (MODE == 0) ? (row < NPR ? p.x_prompt + (size_t)row * 1024 : p.x_sample + (size_t)(row - NPR) * 1024) : p.out + (size_t)row * 1024;
        f32x4 v[4]; float ss = 0.f;
#pragma unroll
        for (int i = 0; i < 4; ++i) { v[i] = *(const f32x4*)(src + i * 256 + 4 * lane); ss += v[i][0] * v[i][0] + v[i][1] * v[i][1] + v[i][2] * v[i][2] + v[i][3] * v[i][3]; }
        ss = wave_sum(ss);
        const float rstd = rsqrtf(ss * (1.f / 1024.f) + 1e-6f);
        if (MODE == 3) {
#pragma unroll
            for (int i = 0; i < 4; ++i) *(f32x4*)(p.out + (size_t)row * 1024 + i * 256 + 4 * lane) = v[i] * rstd * gv[i];
        } else {
            const int b = cond_of_row(row);
            const float* sh = mod + b * 9216 + (MODE * 3) * 1024; const float* scl = sh + 1024;
#pragma unroll
            for (int i = 0; i < 4; ++i) { const f32x4 s4 = *(const f32x4*)(scl + i * 256 + 4 * lane), h4 = *(const f32x4*)(sh + i * 256 + 4 * lane);
                v[i] = v[i] * rstd * gv[i] * (1.f + s4) + h4;
                u32x2 w; w.x = cvt_pk_bf16(v[i][0], v[i][1]); w.y = cvt_pk_bf16(v[i][2], v[i][3]);
                *(u32x2*)(hout + (size_t)row * 1024 + i * 256 + 4 * lane) = w; }
            if (MODE == 1) {
                float my = 0.f;
#pragma unroll
                for (int g = 0; g < 16; ++g) { float a = 0.f;
#pragma unroll
                    for (int i = 0; i < 4; ++i) { const f32x4 w4 = *(const f32x4*)(WgT + g * 1024 + i * 256 + 4 * lane); a += v[i][0] * w4[0] + v[i][1] * w4[1] + v[i][2] * w4[2] + v[i][3] * w4[3]; }
                    a = wave_sum(a); if (lane == g) my = a; }
                if (lane < 16) gates[(size_t)row * 16 + lane] = my + p.b_in[4096 + lane];
            }
        }
    }
    __syncthreads();
}

struct EpiSwiglu {
    static constexpr bool PERM = true, AFTER_DRAIN = false; bf16_t* O;
    DEVI void operator()(const f32x4 (&acc)[2][2][4][2], const Unit& u, int wr, int wc, int fr, int fq) const {
        const int row0 = u.pm * 256 + wr * 64 + fr, col0 = u.pn * 128 + wc * 32 + 8 * fq;
#pragma unroll
        for (int ai = 0; ai < 2; ++ai)
#pragma unroll
            for (int m = 0; m < 4; ++m) { bf16_t* rowp = O + (size_t)(row0 + ai * 128 + m * 16) * 2816 + col0;
                float r[8];
#pragma unroll
                for (int n = 0; n < 2; ++n)
#pragma unroll
                    for (int j = 0; j < 4; ++j) r[4 * n + j] = silu(acc[ai][0][m][n][j]) * acc[ai][1][m][n][j];
                u32x4 w; w.x = cvt_pk_bf16(r[0], r[1]); w.y = cvt_pk_bf16(r[2], r[3]); w.z = cvt_pk_bf16(r[4], r[5]); w.w = cvt_pk_bf16(r[6], r[7]);
                *(u32x4*)rowp = w; }
    }
};
struct EpiResid {
    static constexpr bool PERM = false, AFTER_DRAIN = false; const float* xa; const float* xb; float* xo; const float* gate; float scale;
    DEVI void operator()(const f32x4 (&acc)[2][2][4][2], const Unit& u, int wr, int wc, int fr, int fq) const {
        const int row0 = u.pm * 256 + wr * 64 + fr, col0 = u.pn * 256 + wc * 32 + 4 * fq;
        const float* g = gate + cond_of_row(u.pm * 256) * 9216;
        f32x4 gv[2][2];
#pragma unroll
        for (int bj = 0; bj < 2; ++bj)
#pragma unroll
            for (int n = 0; n < 2; ++n) gv[bj][n] = scale * *(const f32x4*)(g + col0 + bj * 128 + n * 16);
#pragma unroll
        for (int ai = 0; ai < 2; ++ai)
#pragma unroll
            for (int m = 0; m < 4; ++m) { const int row = row0 + ai * 128 + m * 16;
                const float* xi = (row < NPR) ? xa + (size_t)row * 1024 : xb + (size_t)(row - NPR) * 1024; float* xop = xo + (size_t)row * 1024;
#pragma unroll
                for (int bj = 0; bj < 2; ++bj)
#pragma unroll
                    for (int n = 0; n < 2; ++n) { const int c = col0 + bj * 128 + n * 16; const f32x4 xv = *(const f32x4*)(xi + c); *(f32x4*)(xop + c) = xv + gv[bj][n] * acc[ai][bj][m][n]; } }
    }
};
struct EpiZ {
    static constexpr bool PERM = true, AFTER_DRAIN = false; unsigned char* zbase; const float* binp;
    DEVI void operator()(const f32x4 (&acc)[2][2][4][2], const Unit& u, int wr, int wc, int fr, int fq) const {
        const int pn = u.pn, row0 = u.pm * 256 + wr * 64 + fr, cl = wc * 32 + 8 * fq;
        f32x4 bv[2][2];
#pragma unroll
        for (int bj = 0; bj < 2; ++bj)
#pragma unroll
            for (int n = 0; n < 2; ++n) bv[bj][n] = *(const f32x4*)(binp + pn * 256 + bj * 128 + cl + 4 * n);
        if (pn >= 20 && pn < 28) {
            bf16_t* O = (bf16_t*)(zbase + 5 * TB) + (pn - 20) * 128 + cl;
#pragma unroll
            for (int ai = 0; ai < 2; ++ai)
#pragma unroll
                for (int m = 0; m < 4; ++m) { float r[8];
#pragma unroll
                    for (int n = 0; n < 2; ++n)
#pragma unroll
                        for (int j = 0; j < 4; ++j) r[4 * n + j] = (acc[ai][0][m][n][j] + bv[0][n][j]) * (acc[ai][1][m][n][j] + bv[1][n][j]);
                    u32x4 w; w.x = cvt_pk_bf16(r[0], r[1]); w.y = cvt_pk_bf16(r[2], r[3]); w.z = cvt_pk_bf16(r[4], r[5]); w.w = cvt_pk_bf16(r[6], r[7]);
                    *(u32x4*)(O + (size_t)(row0 + ai * 128 + m * 16) * 1024) = w; }
        } else {
            const int seg = pn < 20 ? (pn >> 2) : (pn < 32 ? 6 : 7);
            const int cb = pn < 20 ? (pn & 3) * 256 : ((pn - 28) & 3) * 256;
            const bool sg = (seg == 3) || (seg >= 6); const float mul = (seg == 1) ? 0.0625f : 1.f;
            bf16_t* O = (bf16_t*)(zbase + (size_t)seg * TB) + cb + cl;
#pragma unroll
            for (int ai = 0; ai < 2; ++ai)
#pragma unroll
                for (int m = 0; m < 4; ++m)
#pragma unroll
                    for (int bj = 0; bj < 2; ++bj) { float r[8];
#pragma unroll
                        for (int n = 0; n < 2; ++n)
#pragma unroll
                            for (int j = 0; j < 4; ++j) { float x = (acc[ai][bj][m][n][j] + bv[bj][n][j]) * mul; r[4 * n + j] = sg ? sigm(x) : x; }
                        u32x4 w; w.x = cvt_pk_bf16(r[0], r[1]); w.y = cvt_pk_bf16(r[2], r[3]); w.z = cvt_pk_bf16(r[4], r[5]); w.w = cvt_pk_bf16(r[6], r[7]);
                        *(u32x4*)(O + (size_t)(row0 + ai * 128 + m * 16) * 1024 + bj * 128) = w; }
        }
    }
};
template <int SECOND> struct EpiY {
    static constexpr bool PERM = true, AFTER_DRAIN = false; const bf16_t* gate; bf16_t* Y;
    DEVI void operator()(const f32x4 (&acc)[2][2][4][2], const Unit& u, int wr, int wc, int fr, int fq) const {
        const int row0 = u.pm * 256 + wr * 64 + fr, col0 = u.pn * 256 + wc * 32 + 8 * fq;
#pragma unroll
        for (int ai = 0; ai < 2; ++ai)
#pragma unroll
            for (int m = 0; m < 4; ++m)
#pragma unroll
                for (int bj = 0; bj < 2; ++bj) { const size_t off = (size_t)(row0 + ai * 128 + m * 16) * 1024 + col0 + bj * 128;
                    const u32x4 gw = *(const u32x4*)(gate + off); float r[8];
                    r[0] = bf_lo(gw.x) * acc[ai][bj][m][0][0]; r[1] = bf_hi(gw.x) * acc[ai][bj][m][0][1]; r[2] = bf_lo(gw.y) * acc[ai][bj][m][0][2]; r[3] = bf_hi(gw.y) * acc[ai][bj][m][0][3];
                    r[4] = bf_lo(gw.z) * acc[ai][bj][m][1][0]; r[5] = bf_hi(gw.z) * acc[ai][bj][m][1][1]; r[6] = bf_lo(gw.w) * acc[ai][bj][m][1][2]; r[7] = bf_hi(gw.w) * acc[ai][bj][m][1][3];
                    if (SECOND) { const u32x4 yw = *(const u32x4*)(Y + off);
                        r[0] += bf_lo(yw.x); r[1] += bf_hi(yw.x); r[2] += bf_lo(yw.y); r[3] += bf_hi(yw.y); r[4] += bf_lo(yw.z); r[5] += bf_hi(yw.z); r[6] += bf_lo(yw.w); r[7] += bf_hi(yw.w); }
                    u32x4 w; w.x = cvt_pk_bf16(r[0], r[1]); w.y = cvt_pk_bf16(r[2], r[3]); w.z = cvt_pk_bf16(r[4], r[5]); w.w = cvt_pk_bf16(r[6], r[7]);
                    *(u32x4*)(Y + off) = w; }
    }
};
template <class Epi> DEVI void run_gemm(const bf16_t* A, const bf16_t* Bt, int N, int K, const Epi& E, unsigned char* shm) {
    pg8::Gemm g; g.A = A; g.Bt = Bt; g.M = NTOK; g.N = N; g.K = K;
    pg8::StaticOrder S; S.init(NTOK, N, (int)gridDim.x, (int)blockIdx.x);
    pg8::gemm_phase<Epi, pg8::StaticOrder, false>((PG8_LAS unsigned char*)shm, g, S, E, nullptr);
    __syncthreads();
}

namespace ml {
constexpr int S_OFF = 0, A_OFF = 67584, B_OFF = 86016, T_OFF = 122880, V_OFF = 156672;
template <int NP> DEVI void ld_nat(int tid, u32x4 (&r)[NP], const bf16_t* src, int ld) {
#pragma unroll
    for (int i = 0; i < NP; ++i) { const int idx = tid + 512 * i, row = idx >> 3, cp = idx & 7; r[i] = *(const u32x4*)(src + (size_t)row * ld + cp * 8); }
}
template <int NP> DEVI void st_nat(int tid, const u32x4 (&r)[NP], unsigned char* dst) {
#pragma unroll
    for (int i = 0; i < NP; ++i) { const int idx = tid + 512 * i, row = idx >> 3, cp = idx & 7; *(u32x4*)(dst + row * 144 + cp * 16) = r[i]; }
}
template <int NP> DEVI void ld_tr(int tid, u32x4 (&r)[NP], const bf16_t* src, int ld) {
    constexpr int PPR = NP * 8;
#pragma unroll
    for (int i = 0; i < NP; ++i) { const int idx = tid + 512 * i, kr = idx / PPR, cp = idx % PPR; r[i] = *(const u32x4*)(src + (size_t)kr * ld + cp * 8); }
}
template <int NP> DEVI void st_tr(int tid, const u32x4 (&r)[NP], unsigned char* T) {
    constexpr int PPR = NP * 8;
#pragma unroll
    for (int i = 0; i < NP; ++i) { const int idx = tid + 512 * i, kr = idx / PPR, cp = idx % PPR; *(u32x4*)(T + kr * 528 + cp * 16) = r[i]; }
}
template <int NP, bool SCALE> DEVI void transp(int tid, const unsigned char* T, unsigned char* dst, const float* scale) {
    constexpr int N = NP * 64;
#pragma unroll
    for (int i = 0; i < NP; ++i) { const int idx = tid + 512 * i, n = idx % N, ko = idx / N; float e[8];
#pragma unroll
        for (int j = 0; j < 8; ++j) { e[j] = bf2f(*(const unsigned short*)(T + (8 * ko + j) * 528 + 2 * n)); if (SCALE) e[j] *= scale[8 * ko + j]; }
        u32x4 w; w.x = cvt_pk_bf16(e[0], e[1]); w.y = cvt_pk_bf16(e[2], e[3]); w.z = cvt_pk_bf16(e[4], e[5]); w.w = cvt_pk_bf16(e[6], e[7]);
        *(u32x4*)(dst + n * 144 + ko * 16) = w; }
}
DEVI void mma_slab(f32x4 (&acc)[4][4], const unsigned char* Ab, int astride, const unsigned char* Bb, int wr, int wc, int fr, int fq) {
#pragma unroll
    for (int ks = 0; ks < 2; ++ks) { bf16x8 a[4], b[4];
#pragma unroll
        for (int m = 0; m < 4; ++m) a[m] = *(const bf16x8*)(Ab + (64 * wr + 16 * m + fr) * astride + (32 * ks + 8 * fq) * 2);
#pragma unroll
        for (int n = 0; n < 4; ++n) b[n] = *(const bf16x8*)(Bb + (64 * wc + 16 * n + fr) * 144 + (32 * ks + 8 * fq) * 2);
#pragma unroll
        for (int m = 0; m < 4; ++m)
#pragma unroll
            for (int n = 0; n < 4; ++n) acc[m][n] = __builtin_amdgcn_mfma_f32_16x16x32_bf16(b[n], a[m], acc[m][n], 0, 0, 0); }
}
template <int AM, int BM> DEVI void bgemm(f32x4 (&acc)[4][4], unsigned char* shm, const bf16_t* Asrc, int lda, const bf16_t* Bsrc, int ldb, int nslab, const float* ascale, int a_koff) {
    u32x4 ra[2], rb[4];
    int t = threadIdx.x; asm volatile("" : "+v"(t));
    const int wid = t >> 6, lane = t & 63, wr = wid >> 2, wc = wid & 3, fr = lane & 15, fq = lane >> 4;
    if (AM == 0) ld_nat<2>(t, ra, Asrc, lda); else if (AM == 1) ld_tr<2>(t, ra, Asrc, lda);
    if (BM == 0) ld_nat<4>(t, rb, Bsrc, ldb); else ld_tr<4>(t, rb, Bsrc, ldb);
#pragma unroll 1
    for (int i = 0; i < nslab; ++i) {
        if (AM == 0) st_nat<2>(t, ra, shm + A_OFF); else if (AM == 1) st_tr<2>(t, ra, shm + S_OFF);
        if (BM == 0) st_nat<4>(t, rb, shm + B_OFF); else st_tr<4>(t, rb, shm + T_OFF);
        __syncthreads();
        if (i + 1 < nslab) {
            if (AM == 0) ld_nat<2>(t, ra, Asrc + (i + 1) * 64, lda); else if (AM == 1) ld_tr<2>(t, ra, Asrc + (size_t)(i + 1) * 64 * lda, lda);
            if (BM == 0) ld_nat<4>(t, rb, Bsrc + (i + 1) * 64, ldb); else ld_tr<4>(t, rb, Bsrc + (size_t)(i + 1) * 64 * ldb, ldb);
        }
        if (AM == 1 || BM == 1) {
            if (AM == 1) transp<2, true>(t, shm + S_OFF, shm + A_OFF, ascale + i * 64);
            if (BM == 1) transp<4, false>(t, shm + T_OFF, shm + B_OFF, nullptr);
            __syncthreads();
        }
        mma_slab(acc, (AM == 2) ? (shm + S_OFF + (a_koff + i * 64) * 2) : (shm + A_OFF), (AM == 2) ? 528 : 144, shm + B_OFF, wr, wc, fr, fq);
        __syncthreads();
    }
}
DEVI void zero_acc(f32x4 (&a)[4][4]) {
#pragma unroll
    for (int m = 0; m < 4; ++m)
#pragma unroll
        for (int n = 0; n < 4; ++n) a[m][n] = (f32x4){0.f, 0.f, 0.f, 0.f};
}
DEVI void chain_m(const Params& p, int cgk, int dh, float& m_in, float& m_out) {
    const float* bl = (const float*)(p.ws + OFF_BL) + dh * 48; const float* ml = (const float*)(p.ws + OFF_MLOC) + dh * 48;
    float m = 0.f;
    if (cgk >= 16) { const int lc = cgk - 16, b = lc >> 4, c = lc & 15, base = 16 + b * 16; m = p.state_m[b * 8 + dh];
        if ((dh >> 2) == 0) { for (int cc = 0; cc < c; ++cc) m = fmaxf(bl[base + cc] + m, ml[base + cc]); }
        else { for (int cc = 15; cc > c; --cc) m = fmaxf(bl[base + cc] + m, ml[base + cc]); } }
    m_in = m; m_out = fmaxf(bl[cgk] + m, ml[cgk]);
}
DEVI void m1_item(const Params& p, int item, unsigned char* shm) {
    float* sm = (float*)shm; const int t = threadIdx.x, cgk = item >> 3, dh = item & 7, dir = dh >> 2;
    const float* gates = (const float*)(p.ws + OFF_GATES);
    int tok = 0; float ii = 0.f, v = 0.f;
    if (t < 256) { tok = cgk * 256 + (dir ? 255 - t : t); ii = gates[(size_t)tok * 16 + dh]; const float f = gates[(size_t)tok * 16 + 8 + dh]; v = fminf(f, 0.f) - log1pf(expf(-fabsf(f))); }
    for (int off = 1; off < 256; off <<= 1) { if (t < 256) sm[t] = v; __syncthreads(); if (t < 256 && t >= off) v += sm[t - off]; __syncthreads(); }
    const float b = v, gi = ii - b; float mx = gi;
    for (int off = 1; off < 256; off <<= 1) { if (t < 256) sm[t] = mx; __syncthreads(); if (t < 256 && t >= off) mx = fmaxf(mx, sm[t - off]); __syncthreads(); }
    if (t < 256) { ((float*)(p.ws + OFF_BQ))[dh * NTOK + tok] = b; ((float*)(p.ws + OFF_GI))[dh * NTOK + tok] = gi; ((float*)(p.ws + OFF_PMX))[dh * NTOK + tok] = mx;
        if (t == 255) { ((float*)(p.ws + OFF_BL))[dh * 48 + cgk] = b; ((float*)(p.ws + OFF_MLOC))[dh * 48 + cgk] = b + mx; } }
}
DEVI void m2_item(const Params& p, int item, unsigned char* shm) {
    const int t = threadIdx.x, wid = t >> 6, lane = t & 63, wr = wid >> 2, wc = wid & 3, fr = lane & 15, fq = lane >> 4;
    const int cgk = item >> 4, dh = (item >> 1) & 7, half = item & 1, head = dh & 3, r0 = cgk * 256;
    float m_in, m_out; chain_m(p, cgk, dh, m_in, m_out);
    float* vwk = (float*)(shm + V_OFF);
    const float blv = ((const float*)(p.ws + OFF_BL))[dh * 48 + cgk];
    if (t < 256) vwk[t] = __expf(blv + ((const float*)(p.ws + OFF_GI))[dh * NTOK + r0 + t] - m_out);
    __syncthreads();
    const bf16_t* kb = zbuf(p, 1) + (size_t)r0 * 1024 + head * 256 + 128 * half; const bf16_t* vb = zbuf(p, 2) + (size_t)r0 * 1024 + head * 256;
    f32x4 acc[4][4]; zero_acc(acc);
    bgemm<1, 1>(acc, shm, kb, 1024, vb, 1024, 4, vwk, 0);
    if (t < 128) { float s = 0.f;
#pragma unroll 16
        for (int si = 0; si < 256; ++si) s += vwk[si] * bf2f(kb[(size_t)si * 1024 + t]);
        if (cgk < 16) p.out[(size_t)NTOK * 1024 + (size_t)16 * 8 * 65536 + (cgk * 8 + dh) * 256 + 128 * half + t] = s;
        else ((float*)(p.ws + OFF_DN))[(dh * 48 + cgk) * 256 + 128 * half + t] = s; }
    if (cgk < 16) {
        float* C = p.out + (size_t)NTOK * 1024 + (size_t)(cgk * 8 + dh) * 65536;
#pragma unroll
        for (int m = 0; m < 4; ++m)
#pragma unroll
            for (int n = 0; n < 4; ++n) *(f32x4*)(C + (128 * half + 64 * wr + 16 * m + fr) * 256 + 64 * wc + 16 * n + 4 * fq) = acc[m][n];
        if (half == 0 && t == 0) p.out[(size_t)NTOK * 1024 + (size_t)16 * 8 * 65536 + 16 * 8 * 256 + cgk * 8 + dh] = m_out;
    } else {
        bf16_t* C = (bf16_t*)(p.ws + OFF_CIN) + (size_t)(dh * 32 + (cgk - 16)) * 65536;
#pragma unroll
        for (int m = 0; m < 4; ++m)
#pragma unroll
            for (int n = 0; n < 4; ++n) { u32x2 w; w.x = cvt_pk_bf16(acc[m][n][0], acc[m][n][1]); w.y = cvt_pk_bf16(acc[m][n][2], acc[m][n][3]);
                *(u32x2*)(C + (128 * half + 64 * wr + 16 * m + fr) * 256 + 64 * wc + 16 * n + 4 * fq) = w; }
    }
    __syncthreads();
}
DEVI void m3_phase(const Params& p) {
    const int t = threadIdx.x;
    for (int it = blockIdx.x; it < 256; it += gridDim.x) {
        const int chain = it >> 4, seg = it & 15, b = chain >> 3, dh = chain & 7, dir = dh >> 2;
        const size_t e0 = (size_t)seg * 4096 + t * 8;
        const float* bl = (const float*)(p.ws + OFF_BL) + dh * 48; const float* mlc = (const float*)(p.ws + OFF_MLOC) + dh * 48;
        float st[8]; { const f32x4 a = *(const f32x4*)(p.state_C + (size_t)(b * 8 + dh) * 65536 + e0), c = *(const f32x4*)(p.state_C + (size_t)(b * 8 + dh) * 65536 + e0 + 4);
            st[0] = a[0]; st[1] = a[1]; st[2] = a[2]; st[3] = a[3]; st[4] = c[0]; st[5] = c[1]; st[6] = c[2]; st[7] = c[3]; }
        float sn = (seg == 0 && t < 256) ? p.state_n[(b * 8 + dh) * 256 + t] : 0.f;
        float m = p.state_m[b * 8 + dh];
        for (int step = 0; step < 16; ++step) {
            const int c = dir ? 15 - step : step, cgk = 16 + b * 16 + c;
            const float blv = bl[cgk], m_new = fmaxf(blv + m, mlc[cgk]), decay = __expf(blv + m - m_new);
            bf16_t* ptr = (bf16_t*)(p.ws + OFF_CIN) + (size_t)(dh * 32 + (cgk - 16)) * 65536 + e0;
            const u32x4 dv = *(const u32x4*)ptr;
            u32x4 w; w.x = cvt_pk_bf16(st[0], st[1]); w.y = cvt_pk_bf16(st[2], st[3]); w.z = cvt_pk_bf16(st[4], st[5]); w.w = cvt_pk_bf16(st[6], st[7]);
            *(u32x4*)ptr = w;
            st[0] = decay * st[0] + bf_lo(dv.x); st[1] = decay * st[1] + bf_hi(dv.x); st[2] = decay * st[2] + bf_lo(dv.y); st[3] = decay * st[3] + bf_hi(dv.y);
            st[4] = decay * st[4] + bf_lo(dv.z); st[5] = decay * st[5] + bf_hi(dv.z); st[6] = decay * st[6] + bf_lo(dv.w); st[7] = decay * st[7] + bf_hi(dv.w);
            if (seg == 0 && t < 256) { float* np_ = (float*)(p.ws + OFF_DN) + (dh * 48 + cgk) * 256 + t; const float dnv = *np_; *np_ = sn; sn = decay * sn + dnv; }
            m = m_new;
        }
    }
}
DEVI void conv_phase(const Params& p) {
    const bf16_t* u = zbuf(p, 5); bf16_t* bg = zbuf(p, 4);
    for (int idx = blockIdx.x * 512 + threadIdx.x; idx < NTOK * 128; idx += gridDim.x * 512) {
        const int row = idx >> 7, c8 = (idx & 127) * 8, per = row < NPR ? 256 : 64, pos = row & (per - 1);
        const size_t o = (size_t)row * 1024 + c8;
        const u32x4 z4 = {0u, 0u, 0u, 0u};
        const u32x4 uc = *(const u32x4*)(u + o), um = pos > 0 ? *(const u32x4*)(u + o - 1024) : z4, up = pos < per - 1 ? *(const u32x4*)(u + o + 1024) : z4, bv = *(const u32x4*)(bg + o);
        float r[8];
#pragma unroll
        for (int q = 0; q < 4; ++q) {
            const float w0a = p.conv_w[c8 + 2 * q], w0b = p.conv_w[c8 + 2 * q + 1], w1a = p.conv_w[1024 + c8 + 2 * q], w1b = p.conv_w[1024 + c8 + 2 * q + 1];
            const float w2a = p.conv_w[2048 + c8 + 2 * q], w2b = p.conv_w[2048 + c8 + 2 * q + 1], cba = p.conv_b[c8 + 2 * q], cbb = p.conv_b[c8 + 2 * q + 1];
            r[2 * q] = bf_lo(bv[q]) * (w0a * bf_lo(um[q]) + w1a * bf_lo(uc[q]) + w2a * bf_lo(up[q]) + cba);
            r[2 * q + 1] = bf_hi(bv[q]) * (w0b * bf_hi(um[q]) + w1b * bf_hi(uc[q]) + w2b * bf_hi(up[q]) + cbb); }
        u32x4 w; w.x = cvt_pk_bf16(r[0], r[1]); w.y = cvt_pk_bf16(r[2], r[3]); w.z = cvt_pk_bf16(r[4], r[5]); w.w = cvt_pk_bf16(r[6], r[7]);
        *(u32x4*)(bg + o) = w;
    }
}
DEVI void out_item(const Params& p, int item, unsigned char* shm) {
    const int cgk = item >> 3, head = (item >> 1) & 3, half = item & 1, r0 = cgk * 256, t0 = r0 + 128 * half;
    const bool latent = cgk >= 16;
    bf16_t* qb = zbuf(p, 0) + (size_t)t0 * 1024 + head * 256; const bf16_t* kb = zbuf(p, 1) + (size_t)r0 * 1024 + head * 256;
    const bf16_t* vb = zbuf(p, 2) + (size_t)r0 * 1024 + head * 256; const bf16_t* ob = zbuf(p, 3) + (size_t)t0 * 1024 + head * 256;
    float* vgi = (float*)(shm + V_OFF); float* vmx = vgi + 256; float* vwi = vmx + 128; float* vrd = vwi + 128; float* vmt = vrd + 128; float* red = vmt + 128;
    f32x4 h[4][4]; zero_acc(h);
#pragma unroll 1
    for (int dir = 0; dir < 2; ++dir) {
        int t = threadIdx.x; asm volatile("" : "+v"(t));
        const int wid = t >> 6, lane = t & 63, wr = wid >> 2, wc = wid & 3, fr = lane & 15, fq = lane >> 4;
        const int dh = dir * 4 + head;
        float m_in, m_out; chain_m(p, cgk, dh, m_in, m_out);
        if (t < 256) vgi[t] = ((const float*)(p.ws + OFF_GI))[dh * NTOK + r0 + t];
        if (t < 128) { const float pm = ((const float*)(p.ws + OFF_PMX))[dh * NTOK + t0 + t], mx = fmaxf(m_in, pm);
            vmx[t] = mx; vwi[t] = __expf(m_in - mx); vmt[t] = ((const float*)(p.ws + OFF_BQ))[dh * NTOK + t0 + t] + mx; }
        __syncthreads();
        f32x4 acc[4][4]; zero_acc(acc);
        bgemm<0, 0>(acc, shm, qb, 1024, kb, 1024, 4, nullptr, 0);
#pragma unroll
        for (int m = 0; m < 4; ++m) { const int tl = 64 * wr + 16 * m + fr, tt = 128 * half + tl; const float mx = vmx[tl];
#pragma unroll
            for (int n = 0; n < 4; ++n) { const int s0 = 64 * wc + 16 * n + 4 * fq; float r[4];
#pragma unroll
                for (int j = 0; j < 4; ++j) { const int s = s0 + j; const bool valid = dir == 0 ? (s <= tt) : (s >= tt); r[j] = valid ? acc[m][n][j] * __expf(vgi[s] - mx) : 0.f; }
                u32x2 w; w.x = cvt_pk_bf16(r[0], r[1]); w.y = cvt_pk_bf16(r[2], r[3]); *(u32x2*)(shm + S_OFF + tl * 528 + s0 * 2) = w; } }
        __syncthreads();
        {
            const int row = t >> 2, part = t & 3; float s = 0.f, qn = 0.f;
#pragma unroll
            for (int i = 0; i < 8; ++i) { const u32x4 w = *(const u32x4*)(shm + S_OFF + row * 528 + (64 * part + 8 * i) * 2);
                s += bf_lo(w.x) + bf_hi(w.x) + bf_lo(w.y) + bf_hi(w.y) + bf_lo(w.z) + bf_hi(w.z) + bf_lo(w.w) + bf_hi(w.w); }
            if (latent) { const float* nin = (const float*)(p.ws + OFF_DN) + (dh * 48 + cgk) * 256 + 64 * part;
#pragma unroll
                for (int i = 0; i < 8; ++i) { const u32x4 w = *(const u32x4*)(qb + (size_t)row * 1024 + 64 * part + 8 * i); const f32x4 n0 = *(const f32x4*)(nin + 8 * i), n1 = *(const f32x4*)(nin + 8 * i + 4);
                    qn += bf_lo(w.x) * n0[0] + bf_hi(w.x) * n0[1] + bf_lo(w.y) * n0[2] + bf_hi(w.y) * n0[3] + bf_lo(w.z) * n1[0] + bf_hi(w.z) * n1[1] + bf_lo(w.w) * n1[2] + bf_hi(w.w) * n1[3]; } }
            s += __shfl_xor(s, 1); s += __shfl_xor(s, 2); qn += __shfl_xor(qn, 1); qn += __shfl_xor(qn, 2);
            if (part == 0) { const float den = s + vwi[row] * qn; vrd[row] = 1.f / fmaxf(fabsf(den), __expf(-vmt[row])); }
        }
        __syncthreads();
        zero_acc(acc);
        if (latent) {
            bgemm<0, 1>(acc, shm, qb, 1024, (const bf16_t*)(p.ws + OFF_CIN) + (size_t)(dh * 32 + (cgk - 16)) * 65536, 256, 4, nullptr, 0);
#pragma unroll
            for (int m = 0; m < 4; ++m) { const float wi = vwi[64 * wr + 16 * m + fr];
#pragma unroll
                for (int n = 0; n < 4; ++n) acc[m][n] *= wi; }
        }
        const int s_lo = dir == 0 ? 0 : 2 * half, s_hi = dir == 0 ? 2 * (half + 1) : 4;
        bgemm<2, 1>(acc, shm, nullptr, 0, vb + (size_t)(64 * s_lo) * 1024, 1024, s_hi - s_lo, nullptr, 64 * s_lo);
#pragma unroll
        for (int m = 0; m < 4; ++m) { const float rd = vrd[64 * wr + 16 * m + fr];
#pragma unroll
            for (int n = 0; n < 4; ++n) h[m][n] += acc[m][n] * rd; }
        __syncthreads();
    }
    int t = threadIdx.x; asm volatile("" : "+v"(t));
    const int wid = t >> 6, lane = t & 63, wr = wid >> 2, wc = wid & 3, fr = lane & 15, fq = lane >> 4;
    float ss[4];
#pragma unroll
    for (int m = 0; m < 4; ++m) { float a = 0.f;
#pragma unroll
        for (int n = 0; n < 4; ++n) a += h[m][n][0] * h[m][n][0] + h[m][n][1] * h[m][n][1] + h[m][n][2] * h[m][n][2] + h[m][n][3] * h[m][n][3];
        a += __shfl_xor(a, 16); a += __shfl_xor(a, 32); ss[m] = a; }
    if (fq == 0) {
#pragma unroll
        for (int m = 0; m < 4; ++m) red[(64 * wr + 16 * m + fr) * 4 + wc] = ss[m]; }
    __syncthreads();
#pragma unroll
    for (int m = 0; m < 4; ++m) { const int tl = 64 * wr + 16 * m + fr; const f32x4 rr = *(const f32x4*)(red + tl * 4);
        const float rstd = rsqrtf((rr[0] + rr[1] + rr[2] + rr[3]) * (1.f / 256.f) + 1e-6f);
#pragma unroll
        for (int n = 0; n < 4; ++n) { const int col = 64 * wc + 16 * n + 4 * fq; const f32x4 mn = *(const f32x4*)(p.ml_norm + head * 256 + col);
            const u32x2 ow = *(const u32x2*)(ob + (size_t)tl * 1024 + col);
            u32x2 w; w.x = cvt_pk_bf16(h[m][n][0] * rstd * mn[0] * bf_lo(ow.x), h[m][n][1] * rstd * mn[1] * bf_hi(ow.x));
            w.y = cvt_pk_bf16(h[m][n][2] * rstd * mn[2] * bf_lo(ow.y), h[m][n][3] * rstd * mn[3] * bf_hi(ow.y));
            *(u32x2*)(qb + (size_t)tl * 1024 + col) = w; } }
    __syncthreads();
}
}

__global__ __launch_bounds__(512, 2) void mega(Params p) {
    extern __shared__ __attribute__((aligned(16))) unsigned char shm[];
    cg::grid_group grid = cg::this_grid();
    const int lo = p.phase_lo, hi = p.phase_hi;
#ifdef ONLY
#define PH(k) if ((k) == ONLY)
#else
#define PH(k) if (lo <= (k) && (k) < hi)
#endif
#define SYNC(k) if (lo <= (k) && (k) + 1 < hi) grid.sync()
    float* mod = (float*)(p.ws + OFF_MOD);
    bf16_t* hbuf = (bf16_t*)(p.out + (size_t)NTOK * 1024);
    bf16_t* act = (bf16_t*)(p.ws + OFF_Z);
    PH(0) phase0(p, shm);
    SYNC(0);
    PH(1) row_phase<0>(p, shm);
    SYNC(1);
    PH(2) { EpiSwiglu E; E.O = act; run_gemm(hbuf, (const bf16_t*)(p.ws + OFF_W1T), 5632, 1024, E, shm); }
    SYNC(2);
    PH(3) { EpiResid E; E.xa = p.x_prompt; E.xb = p.x_sample; E.xo = p.out; E.gate = mod + 2 * 1024; E.scale = 0.5f; run_gemm(act, (const bf16_t*)(p.ws + OFF_W2T), 1024, 2816, E, shm); }
    SYNC(3);
    PH(4) row_phase<1>(p, shm);
    SYNC(4);
    PH(5) {
        for (int it = blockIdx.x; it < 384; it += gridDim.x) ml::m1_item(p, it, shm);
        __syncthreads();
        EpiZ E; E.zbase = p.ws + OFF_Z; E.binp = (const float*)(p.ws + OFF_BINP); run_gemm(hbuf, (const bf16_t*)(p.ws + OFF_WIN), 9216, 1024, E, shm);
    }
    SYNC(5);
    PH(6) { for (int it = blockIdx.x; it < 768; it += gridDim.x) ml::m2_item(p, it, shm); ml::conv_phase(p); }
    SYNC(6);
    PH(7) ml::m3_phase(p);
    SYNC(7);
    PH(8) { for (int it = (int)gridDim.x - 1 - (int)blockIdx.x + 0; it < 384; it += gridDim.x) ml::out_item(p, 383 - it, shm); }
    SYNC(8);
    PH(9) {
        { EpiY<0> E; E.gate = zbuf(p, 6); E.Y = zbuf(p, 1); run_gemm(zbuf(p, 0), (const bf16_t*)(p.ws + OFF_WML), 1024, 1024, E, shm); }
        { EpiY<1> E; E.gate = zbuf(p, 7); E.Y = zbuf(p, 1); run_gemm(zbuf(p, 4), (const bf16_t*)(p.ws + OFF_WSC), 1024, 1024, E, shm); }
    }
    SYNC(9);
    PH(10) {
        for (int it = (int)gridDim.x - 1 - (int)blockIdx.x; it < 528; it += gridDim.x) conv_ffn(p.ffn2_w1, p.ffn2_w2, p, it, shm);
        EpiResid E; E.xa = p.out; E.xb = p.out + (size_t)NPR * 1024; E.xo = p.out; E.gate = mod + 5 * 1024; E.scale = 1.0f; run_gemm(zbuf(p, 1), (const bf16_t*)(p.ws + OFF_WO), 1024, 1024, E, shm);
    }
    SYNC(10);
    PH(11) row_phase<2>(p, shm);
    SYNC(11);
    PH(12) { EpiSwiglu E; E.O = act; run_gemm(zbuf(p, 7), (const bf16_t*)(p.ws + OFF_W1T), 5632, 1024, E, shm); }
    SYNC(12);
    PH(13) { EpiResid E; E.xa = p.out; E.xb = p.out + (size_t)NPR * 1024; E.xo = p.out; E.gate = mod + 8 * 1024; E.scale = 0.5f; run_gemm(act, (const bf16_t*)(p.ws + OFF_W2T), 1024, 2816, E, shm); }
    SYNC(13);
    PH(14) row_phase<3>(p, shm);
}

extern "C" void kernel_launch(void* const* d_in, const int* in_sizes, int n_in, void* d_out, int out_size, void* d_ws, size_t ws_size, hipStream_t stream) {
    static int grid_blocks = 0;
    if (!grid_blocks) {
        int dev = 0, cus = 0, per_cu = 0;
        hipGetDevice(&dev);
        hipDeviceGetAttribute(&cus, hipDeviceAttributeMultiprocessorCount, dev);
        hipFuncSetAttribute((const void*)mega, hipFuncAttributeMaxDynamicSharedMemorySize, LDS_BYTES);
        hipOccupancyMaxActiveBlocksPerMultiprocessor(&per_cu, mega, 512, LDS_BYTES);
        if (per_cu < 1) { fprintf(stderr, "occupancy query returned %d\n", per_cu); per_cu = 1; }
        grid_blocks = cus * per_cu;
    }
    Params p{};
    const float** f = (const float**)&p;
    for (int i = 0; i < 23; ++i) f[i] = (const float*)d_in[i];
    p.out = (float*)d_out; p.ws = (unsigned char*)d_ws;
#if COOP
    p.phase_lo = 0; p.phase_hi = 15;
    void* args[] = {&p};
    hipError_t e = hipLaunchCooperativeKernel((void*)mega, dim3(grid_blocks), dim3(512), args, LDS_BYTES, stream);
    if (e != hipSuccess) fprintf(stderr, "cooperative launch failed: %s (grid %d)\n", hipGetErrorString(e), grid_blocks);
#else
    for (int ph = 0; ph < 15; ++ph) { p.phase_lo = ph; p.phase_hi = ph + 1; hipLaunchKernelGGL(mega, dim3(grid_blocks), dim3(512), LDS_BYTES, stream, p); }
#endif
}
```

```cpp
#include <hip/hip_runtime.h>
#include <hip/hip_cooperative_groups.h>
#include <cstdio>
namespace cg = cooperative_groups;
namespace pg8 {
#define PG8_LAS __attribute__((address_space(3)))
typedef unsigned short bf16_t;
typedef short bf16x8 __attribute__((ext_vector_type(8)));
typedef float f32x4 __attribute__((ext_vector_type(4)));
typedef unsigned u32x4 __attribute__((ext_vector_type(4)));
constexpr int BM = 256, BK = 64, HALF = 128, HTB = HALF * BK * 2  , STAGE_BYTES = 8 * HTB, NXCD = 8, WGM = 8;

__host__ __device__ __forceinline__ int lds_byte(int r, int c) { const int st = (r >> 4) * 2 + (c >> 5), rr = r & 15, cc = c & 31, ob = rr * 64 + cc * 2; return st * 1024 + (ob ^ (((ob >> 9) & 1) << 5)); }
__host__ __device__ __forceinline__ void stage_rc(int b, int& R, int& C) { const int st = b / 1024, sb = b % 1024, swz = sb ^ (((sb >> 9) & 1) << 5); R = (st >> 1) * 16 + swz / 64; C = (st & 1) * 32 + (swz % 64) / 2; }
__host__ __device__ __forceinline__ int perm32(int rho) { const int n = rho >> 4, i = rho & 15; return 8 * (i >> 2) + 4 * n + (i & 3); }

struct Unit { int pm, pn; };
struct Gemm { const bf16_t* A; const bf16_t* Bt; int M, N, K; };
struct StaticOrder {
    int nM, nN, nwg, G, c;
    __host__ __device__ void init(int M, int N, int G_, int c_, int rows = BM) { nM = M / rows; nN = N / BM; nwg = nM * nN; G = G_; c = c_; }
    __host__ __device__ bool next(int i, Unit& u) const {
        const long L = (long)i * G + c; if (L >= nwg) return false;
        int wgid = (int)L; { const int q = nwg / NXCD, r = nwg % NXCD, xcd = wgid % NXCD, off = wgid / NXCD; wgid = (xcd < r ? xcd * (q + 1) : r * (q + 1) + (xcd - r) * q) + off; }
        const int nig = WGM * nN, gid = wgid / nig, fm = gid * WGM, gsz = (nM - fm) < WGM ? (nM - fm) : WGM;
        u.pm = fm + ((wgid % nig) % gsz); u.pn = (wgid % nig) / gsz; return true;
    }
    __device__ __forceinline__ void a_ready(const Unit&) const {}
    __device__ __forceinline__ void done(const Unit&) const {}
};
__device__ __forceinline__ unsigned cvt_pk_bf16(float lo, float hi) { unsigned r; asm volatile("v_cvt_pk_bf16_f32 %0, %1, %2" : "=v"(r) : "v"(lo), "v"(hi)); return r; }
template <class Epi, class Sched, bool STAMP = false, int MT = 4>
__device__ __forceinline__ void gemm_phase(PG8_LAS unsigned char* lds, const Gemm g, const Sched& S, const Epi& E, unsigned long long* stamps) {
    const int tid = threadIdx.x, wid = __builtin_amdgcn_readfirstlane(tid >> 6), lane = tid & 63, wr = wid >> 2, wc = wid & 3, fr = lane & 15, fq = lane >> 4;
    const int K = g.K, nt = K / BK;
    int ts_lo = 0, ts_hi = 0, nts = 0; const unsigned long long rt_entry = STAMP ? (unsigned long long)wall_clock64() : 0ull;
#define PG8_STAMP() do { if (STAMP && wid == 0 && nts < 64) { const unsigned long long _c = (unsigned long long)clock64(); \
        ts_lo = (lane == nts) ? (int)(unsigned)_c : ts_lo; ts_hi = (lane == nts) ? (int)(unsigned)(_c >> 32) : ts_hi; ++nts; } } while (0)
    PG8_STAMP();
    unsigned voffA[2], voffB[2];
#pragma unroll
    for (int i = 0; i < 2; ++i) { int R, C; stage_rc(tid * 16 + i * 8192, R, C); const int Rb = Epi::PERM ? ((R & ~31) + perm32(R & 31)) : R;
        voffA[i] = (unsigned)(R * K + C) * 2u; voffB[i] = (unsigned)(Rb * K + C) * 2u; }
    const size_t kstep = (size_t)(BK * 2);
    const size_t hstep = (size_t)HALF * K * 2;
    const size_t tstep = 2 * hstep; const size_t hstepA = (size_t)(32 * MT) * K * 2, tstepA = 2 * hstepA;
    const unsigned ldsw = (unsigned)wid * 1024u;
    const int aoff = lds_byte(wr * 16 * MT + fr, fq * 8), boff = lds_byte(wc * 32 + fr, fq * 8);
#define PG8_SA(b, h) (((b) * 2 + (h)) * HTB)
#define PG8_SB(b, h) ((4 + (b) * 2 + (h)) * HTB)
#define PG8_STAGE(bufoff, gbase, voff) do { _Pragma("unroll") for (int _i = 0; _i < 2; ++_i) \
        __builtin_amdgcn_global_load_lds((const unsigned*)((const char*)(gbase) + (voff)[_i]), (PG8_LAS unsigned*)(lds + (bufoff) + ldsw + _i * 8192), 16, 0, 0); } while (0)
#define PG8_LDA(dst, b, h) do { _Pragma("unroll") for (int m = 0; m < MT; ++m) _Pragma("unroll") for (int k = 0; k < 2; ++k) dst[m][k] = *(const PG8_LAS bf16x8*)(lds + PG8_SA(b, h) + aoff + m * 2048 + k * 1024); } while (0)
#define PG8_LDB(dst, b, h) do { _Pragma("unroll") for (int n = 0; n < 2; ++n) _Pragma("unroll") for (int k = 0; k < 2; ++k) dst[n][k] = *(const PG8_LAS bf16x8*)(lds + PG8_SB(b, h) + boff + n * 2048 + k * 1024); } while (0)
#define PG8_MMA(ai, bj, At, Bt) do { __builtin_amdgcn_s_setprio(1); _Pragma("unroll") for (int m = 0; m < MT; ++m) _Pragma("unroll") for (int n = 0; n < 2; ++n) _Pragma("unroll") for (int k = 0; k < 2; ++k) \
        acc[ai][bj][m][n] = __builtin_amdgcn_mfma_f32_16x16x32_bf16(Bt[n][k], At[m][k], acc[ai][bj][m][n], 0, 0, 0); __builtin_amdgcn_s_setprio(0); } while (0)
#define PG8_WAIT_V(n) asm volatile("s_waitcnt vmcnt(" #n ")" ::: "memory")
#define PG8_WAIT_L(n) asm volatile("s_waitcnt lgkmcnt(" #n ")" ::: "memory")
#define PG8_BAR __builtin_amdgcn_s_barrier()
#define PG8_SCHED __builtin_amdgcn_sched_barrier(0)
    Unit cur, nxt; int ui = 0;
    if (!S.next(0, cur)) return;
    f32x4 acc[2][2][MT][2];
#pragma unroll
    for (int a = 0; a < 2; ++a)
#pragma unroll
        for (int b = 0; b < 2; ++b)
#pragma unroll
            for (int m = 0; m < MT; ++m)
#pragma unroll
                for (int n = 0; n < 2; ++n) acc[a][b][m][n] = (f32x4){0.f, 0.f, 0.f, 0.f};
    bf16x8 At[MT][2], B0[2][2], B1[2][2];
    const char* cA = (const char*)g.A + (size_t)cur.pm * tstepA; const char* cB = (const char*)g.Bt + (size_t)cur.pn * tstep;
    S.a_ready(cur);
    PG8_STAGE(PG8_SB(0, 0), cB, voffB); PG8_STAGE(PG8_SA(0, 0), cA, voffA); PG8_STAGE(PG8_SB(0, 1), cB + hstep, voffB); PG8_STAGE(PG8_SA(0, 1), cA + hstepA, voffA);
    if (wr == 1) PG8_BAR;
    PG8_WAIT_V(4); PG8_BAR;
    PG8_STAGE(PG8_SB(1, 0), cB + kstep, voffB); PG8_STAGE(PG8_SA(1, 0), cA + kstep, voffA); PG8_STAGE(PG8_SB(1, 1), cB + hstep + kstep, voffB);
    PG8_WAIT_V(6); PG8_BAR;
    PG8_STAMP();
    for (;;) {
        const bool has_next = S.next(ui + 1, nxt);
        const char* nA = has_next ? (const char*)g.A + (size_t)nxt.pm * tstepA : cA; const char* nB = has_next ? (const char*)g.Bt + (size_t)nxt.pn * tstep : cB;
        for (int t = 0; t < nt; t += 2) {
            const bool last = (t == nt - 2);
            const char* a1 = cA + (size_t)(t + 1) * kstep;
            const char* a2 = last ? nA : cA + (size_t)(t + 2) * kstep; const char* b2 = last ? nB : cB + (size_t)(t + 2) * kstep;
            const char* a3 = a2 + kstep; const char* b3 = b2 + kstep;
            if (last && has_next) S.a_ready(nxt);
            PG8_LDB(B0, 0, 0); PG8_SCHED; PG8_LDA(At, 0, 0); PG8_STAGE(PG8_SA(1, 1), a1 + hstepA, voffA);
            if constexpr (MT == 4) PG8_WAIT_L(8); else PG8_WAIT_L(6); PG8_BAR; PG8_WAIT_L(0); PG8_MMA(0, 0, At, B0); PG8_BAR; PG8_SCHED;
            PG8_LDB(B1, 0, 1); PG8_STAGE(PG8_SB(0, 0), b2, voffB);
            PG8_BAR; PG8_WAIT_L(0); PG8_MMA(0, 1, At, B1); PG8_BAR;
            PG8_LDA(At, 0, 1); PG8_STAGE(PG8_SA(0, 0), a2, voffA);
            PG8_BAR; PG8_WAIT_L(0); PG8_MMA(1, 0, At, B0); PG8_BAR; PG8_SCHED;
            PG8_STAGE(PG8_SB(0, 1), b2 + hstep, voffB);
            PG8_WAIT_V(6); PG8_BAR; PG8_MMA(1, 1, At, B1); PG8_BAR;
            PG8_LDB(B0, 1, 0); PG8_SCHED; PG8_LDA(At, 1, 0); PG8_STAGE(PG8_SA(0, 1), a2 + hstepA, voffA);
            if constexpr (MT == 4) PG8_WAIT_L(8); else PG8_WAIT_L(6); PG8_BAR; PG8_WAIT_L(0); PG8_MMA(0, 0, At, B0); PG8_BAR; PG8_SCHED;
            PG8_LDB(B1, 1, 1); PG8_STAGE(PG8_SB(1, 0), b3, voffB);
            PG8_BAR; PG8_WAIT_L(0); PG8_MMA(0, 1, At, B1); PG8_BAR;
            PG8_LDA(At, 1, 1); PG8_STAGE(PG8_SA(1, 0), a3, voffA);
            PG8_BAR; PG8_WAIT_L(0); PG8_MMA(1, 0, At, B0); PG8_BAR; PG8_SCHED;
            PG8_STAGE(PG8_SB(1, 1), b3 + hstep, voffB);
            PG8_WAIT_V(6); PG8_BAR; PG8_MMA(1, 1, At, B1); PG8_BAR;
        }
        PG8_STAMP();
        if constexpr (!Epi::AFTER_DRAIN) { E(acc, cur, wr, wc, fr, fq); S.done(cur); }
        PG8_STAMP();
        if (!has_next) break;
#pragma unroll
        for (int a = 0; a < 2; ++a)
#pragma unroll
            for (int b = 0; b < 2; ++b)
#pragma unroll
                for (int m = 0; m < MT; ++m)
#pragma unroll
                    for (int n = 0; n < 2; ++n) acc[a][b][m][n] = (f32x4){0.f, 0.f, 0.f, 0.f};
        cur = nxt; cA = nA; cB = nB; ++ui;
    }
    PG8_WAIT_V(0);
    if (wr == 0) PG8_BAR;
    PG8_BAR;
    if constexpr (Epi::AFTER_DRAIN) { E.fused(acc, cur, wr, wc, fr, fq, lds, wid, lane); S.done(cur); }
    PG8_STAMP();
    if (STAMP && wid == 0) { stamps[lane] = lane < nts ? (((unsigned long long)(unsigned)ts_hi << 32) | (unsigned)ts_lo) : 0ull;
        if (lane == 62) stamps[62] = rt_entry; if (lane == 63) stamps[63] = (unsigned long long)wall_clock64(); }
#undef PG8_STAMP
#undef PG8_SA
#undef PG8_SB
#undef PG8_STAGE
#undef PG8_LDA
#undef PG8_LDB
#undef PG8_MMA
#undef PG8_WAIT_V
#undef PG8_WAIT_L
#undef PG8_BAR
#undef PG8_SCHED
}
}
using pg8::bf16_t; using pg8::bf16x8; using pg8::f32x4; using pg8::u32x4; using pg8::cvt_pk_bf16; using pg8::Unit;
typedef unsigned u32x2 __attribute__((ext_vector_type(2)));
#define DEVI __device__ __forceinline__
#define LBAR() do { asm volatile("s_waitcnt lgkmcnt(0)" ::: "memory"); __builtin_amdgcn_s_barrier(); asm volatile("" ::: "memory"); } while (0)
#define LAS __attribute__((address_space(3)))
#define XB_TMO      128
#define XB_XCNT(j)  (256  + 64 * (j))
#define XB_XSUB(j)  (1280 + 64 * (j))
#define XB_XGEN(j)  (2304 + 64 * (j))
#define XB_TOP      3328
#define XB_TOPGEN   3392
#define XCD_BAR_WORDS 3456
#define XB_SPIN_CAP (1u << 18)

__device__ __forceinline__ unsigned xb_ld(unsigned* p)              { return __hip_atomic_load(p, __ATOMIC_RELAXED, __HIP_MEMORY_SCOPE_AGENT); }
__device__ __forceinline__ unsigned xb_add(unsigned* p, unsigned v) { return __hip_atomic_fetch_add(p, v, __ATOMIC_RELAXED, __HIP_MEMORY_SCOPE_AGENT); }
__device__ __forceinline__ unsigned xb_xcc_id() { return (unsigned)__builtin_amdgcn_s_getreg((3 << 11) | 20) & 0xFu; }
#define XB_SPIN(cond, bar) do { unsigned _sp = 0; while (cond) { __builtin_amdgcn_s_sleep(1); \
    if ((++_sp & 255u) == 0u) { if (xb_ld(&(bar)[XB_TMO])) break; if (_sp > XB_SPIN_CAP) { atomicAdd(&(bar)[XB_TMO], 1u); break; } } } } while (0)

struct XcdBarrier {
    unsigned* bar; unsigned x;
    volatile LAS unsigned* st;
};

__device__ __forceinline__ XcdBarrier xcd_barrier_post(unsigned* bar, volatile LAS unsigned* st) {
    XcdBarrier b; b.bar = bar; b.x = xb_xcc_id(); b.st = st;
    if (threadIdx.x == 0) (void)xb_add(&bar[XB_XCNT(b.x)], 1u);
    return b;
}
__device__ __forceinline__ void xcd_barrier_complete(unsigned* bar, unsigned x, unsigned& nloc, unsigned& nx) {
    const unsigned G = gridDim.x * gridDim.y * gridDim.z;
    unsigned sum, cnt, mine, sp = 0u;
    for (;;) {
        sum = 0u; cnt = 0u; mine = 0u;
#pragma unroll
        for (unsigned j = 0; j < 16; ++j) { const unsigned c = xb_ld(&bar[XB_XCNT(j)]); sum += c; cnt += (c > 0u) ? 1u : 0u; mine = (j == x) ? c : mine; }
        if (sum == G) break;
        __builtin_amdgcn_s_sleep(1);
        if ((++sp & 255u) == 0u) { if (xb_ld(&bar[XB_TMO])) break; if (sp > XB_SPIN_CAP) { atomicAdd(&bar[XB_TMO], 1u); break; } }
    }
    nloc = mine > 0u ? mine : 1u; nx = cnt > 0u ? cnt : 1u;
}

__device__ __forceinline__ void xcd_barrier(const XcdBarrier& b) {
    asm volatile("s_waitcnt vmcnt(0)" ::: "memory");
    __syncthreads();
    if (threadIdx.x == 0) {
        unsigned* bar = b.bar;
        __builtin_amdgcn_s_waitcnt(0);
        unsigned nloc = b.st[0], nx = b.st[1];
        if (nloc == 0u) { xcd_barrier_complete(bar, b.x, nloc, nx); b.st[0] = nloc; b.st[1] = nx; }
        const unsigned old = xb_add(&bar[XB_XSUB(b.x)], 1u);
        const unsigned gen = old / nloc;
        if (old + 1u == (gen + 1u) * nloc) {
            __builtin_amdgcn_fence(__ATOMIC_RELEASE, "agent");
            asm volatile("s_waitcnt vmcnt(0)" ::: "memory");
            const unsigned og = xb_add(&bar[XB_TOP], 1u);
            const unsigned tg = og / nx;
            if (og + 1u == (tg + 1u) * nx) xb_add(&bar[XB_TOPGEN], 1u);
            else XB_SPIN(xb_ld(&bar[XB_TOPGEN]) == tg, bar);
            __builtin_amdgcn_fence(__ATOMIC_ACQUIRE, "agent");
            xb_add(&bar[XB_XGEN(b.x)], 1u);
            asm volatile("s_waitcnt vmcnt(0)" ::: "memory");
        } else {
            XB_SPIN(xb_ld(&bar[XB_XGEN(b.x)]) == gen, bar);
            __builtin_amdgcn_fence(__ATOMIC_ACQUIRE, "agent");
            asm volatile("s_waitcnt vmcnt(0)" ::: "memory");
        }
    }
    __syncthreads();
}


#ifndef GMT
#define GMT 3
#endif
#ifndef COOP
#define COOP 1
#endif

constexpr int NTOK = 12288, NPR = 4096;
constexpr size_t MiB = (size_t)1 << 20, KiB = 1024;
constexpr size_t OFF_W1T = 0, OFF_W2T = 11 * MiB, OFF_WIN = 16 * MiB + 512 * KiB, OFF_CIN = 0;
constexpr size_t OFF_WML = 34 * MiB + 512 * KiB, OFF_WSC = OFF_WML + 2 * MiB, OFF_WO = OFF_WSC + 2 * MiB;
constexpr size_t OFF_MOD = 40 * MiB + 512 * KiB, OFF_BINP = OFF_MOD + 112 * KiB, OFF_GATES = OFF_BINP + 40 * KiB;
constexpr size_t OFF_BQ = OFF_GATES + 768 * KiB, OFF_GI = OFF_BQ + 384 * KiB, OFF_PMX = OFF_GI + 384 * KiB;
constexpr size_t OFF_BL = OFF_PMX + 384 * KiB, OFF_MLOC = OFF_BL + 4 * KiB, OFF_DN = OFF_MLOC + 4 * KiB;
constexpr size_t OFF_BAR = OFF_DN + 384 * KiB;
constexpr size_t OFF_Z = 44 * MiB, TB = 24 * MiB;
constexpr size_t OFF_F2 = 236 * MiB;
constexpr int ST_OFF = 161792;
constexpr int LDS_BYTES = 162048;

struct Params {
    const float *x_prompt, *x_sample, *state_C, *state_n, *state_m, *c, *c_ctx, *w_mod, *b_mod, *norm_g, *ffn1_w1, *ffn1_w2, *w_in, *b_in,
        *conv_w, *conv_b, *ml_norm, *w_ml_out, *w_sc_out, *w_o, *ffn2_w1, *ffn2_w2, *final_norm;
    float* out; unsigned char* ws; int phase_lo, phase_hi, rep_mask, pad_;
};

DEVI float bf2f(unsigned short b) { return __uint_as_float(((unsigned)b) << 16); }
DEVI float bf_lo(unsigned u) { return __uint_as_float(u << 16); }
DEVI float bf_hi(unsigned u) { return __uint_as_float(u & 0xffff0000u); }
DEVI unsigned short f2bf(float f) { return (unsigned short)(cvt_pk_bf16(f, f) & 0xffffu); }
DEVI float sigm(float x) { return 1.f / (1.f + __expf(-x)); }
DEVI float silu(float x) { return x / (1.f + __expf(-x)); }
DEVI int cond_of_row(int row) { return row < NPR ? 0 : 1 + ((row - NPR) >> 12); }
DEVI bf16_t* zbuf(const Params& p, int i) { return (bf16_t*)(p.ws + OFF_Z + (size_t)i * TB); }
DEVI float wave_sum(float v) { v += __shfl_xor(v, 32); v += __shfl_xor(v, 16); v += __shfl_xor(v, 8); v += __shfl_xor(v, 4); v += __shfl_xor(v, 2); v += __shfl_xor(v, 1); return v; }

DEVI int win_src_col(int L) {
    if (L < 4096) return L;
    if (L < 5120) return 4112 + (L - 4096);
    if (L < 7168) { const int o = L - 5120, j = o >> 8, w = o & 255; return (w < 128) ? (5136 + 128 * j + w) : (6160 + 128 * j + (w - 128)); }
    if (L < 8192) return 7184 + (L - 7168);
    return 8208 + (L - 8192);
}
DEVI int w1_src_col(int L) { const int j = L >> 8, w = L & 255; return (w < 128) ? (128 * j + w) : (2816 + 128 * j + (w - 128)); }

DEVI void conv_tile(const float* __restrict__ src, int ldsrc, int col0, bf16_t* __restrict__ dst, int Ktot, int L0, int k0, unsigned char* shm) {
    unsigned short* T = (unsigned short*)shm;
    const int t = threadIdx.x, nq = t & 15, kr = t >> 4;
#pragma unroll
    for (int ps = 0; ps < 8; ++ps) { const int k = ps * 32 + kr; const f32x4 v4_ = __builtin_nontemporal_load((const f32x4*)(src + (size_t)(k0 + k) * ldsrc + col0 + 4 * nq)); float4 v; v.x = v4_[0]; v.y = v4_[1]; v.z = v4_[2]; v.w = v4_[3];
        T[(4 * nq + 0) * 258 + k] = f2bf(v.x); T[(4 * nq + 1) * 258 + k] = f2bf(v.y); T[(4 * nq + 2) * 258 + k] = f2bf(v.z); T[(4 * nq + 3) * 258 + k] = f2bf(v.w); }
    __syncthreads();
#pragma unroll
    for (int ps = 0; ps < 4; ++ps) { const int n = ps * 16 + (t >> 5), k8 = (t & 31) * 8; const unsigned* s = (const unsigned*)(T + n * 258 + k8);
        u32x4 w; w.x = s[0]; w.y = s[1]; w.z = s[2]; w.w = s[3]; *(u32x4*)(dst + (size_t)(L0 + n) * Ktot + k0 + k8) = w; }
    __syncthreads();
}
DEVI void conv_ffn(const float* w1, const float* w2, size_t off, const Params& p, int it, unsigned char* shm) {
    if (it < 352) { const int nb = it >> 2, kb = it & 3; conv_tile(w1, 5632, w1_src_col(64 * nb), (bf16_t*)(p.ws + off), 1024, 64 * nb, 256 * kb, shm); }
    else { const int i2 = it - 352, nb = i2 / 11, kb = i2 % 11; conv_tile(w2, 1024, 64 * nb, (bf16_t*)(p.ws + off + 11 * MiB), 2816, 64 * nb, 256 * kb, shm); }
}
struct ConvDesc { const float* src; bf16_t* dst; int ldsrc, col0, Ktot, L0, k0; };
DEVI ConvDesc conv_desc(const Params& p, int list, int it) {
    ConvDesc d;
    if (it < 352) { const int nb = it >> 2, kb = it & 3; d.src = list ? p.ffn2_w1 : p.ffn1_w1; d.ldsrc = 5632; d.col0 = w1_src_col(64 * nb); d.dst = (bf16_t*)(p.ws + (list ? OFF_F2 : OFF_W1T)); d.Ktot = 1024; d.L0 = 64 * nb; d.k0 = 256 * kb; }
    else if (it < 528) { const int i2 = it - 352, nb = i2 / 11, kb = i2 % 11; d.src = list ? p.ffn2_w2 : p.ffn1_w2; d.ldsrc = 1024; d.col0 = 64 * nb; d.dst = (bf16_t*)(p.ws + (list ? OFF_F2 : OFF_W1T) + 11 * MiB); d.Ktot = 2816; d.L0 = 64 * nb; d.k0 = 256 * kb; }
    else if (it < 1104) { const int i2 = it - 528, nb = i2 >> 2, kb = i2 & 3; d.src = p.w_in; d.ldsrc = 9232; d.col0 = win_src_col(64 * nb); d.dst = (bf16_t*)(p.ws + OFF_WIN); d.Ktot = 1024; d.L0 = 64 * nb; d.k0 = 256 * kb; }
    else { const int i2 = it - 1104, mtx = i2 >> 6, i3 = i2 & 63, nb = i3 >> 2, kb = i3 & 3;
        d.src = mtx == 0 ? p.w_ml_out : (mtx == 1 ? p.w_sc_out : p.w_o); d.dst = (bf16_t*)(p.ws + (mtx == 0 ? OFF_WML : (mtx == 1 ? OFF_WSC : OFF_WO)));
        d.ldsrc = 1024; d.col0 = 64 * nb; d.Ktot = 1024; d.L0 = 64 * nb; d.k0 = 256 * kb; }
    return d;
}
DEVI void conv_load(f32x4 (&r)[8], const ConvDesc& d) {
    const int t = threadIdx.x, nq = t & 15, kp = t >> 4;
#pragma unroll
    for (int ps = 0; ps < 4; ++ps) { const float* s = d.src + (size_t)(d.k0 + ps * 64 + 2 * kp) * d.ldsrc + d.col0 + 4 * nq;
        r[2 * ps] = __builtin_nontemporal_load((const f32x4*)s); r[2 * ps + 1] = __builtin_nontemporal_load((const f32x4*)(s + d.ldsrc)); }
}
DEVI void conv_items(const Params& p, unsigned char* shm, int list, int first, int end, int stride) {
    if (first >= end) return;
    unsigned* T = (unsigned*)shm;
    const int t = threadIdx.x, nq = t & 15, kp = t >> 4;
    f32x4 r[8];
    ConvDesc d = conv_desc(p, list, first); conv_load(r, d);
#pragma unroll 1
    for (int it = first; it < end; it += stride) {
#pragma unroll
        for (int ps = 0; ps < 4; ++ps)
#pragma unroll
            for (int j = 0; j < 4; ++j) T[(4 * nq + j) * 129 + ps * 32 + kp] = cvt_pk_bf16(r[2 * ps][j], r[2 * ps + 1][j]);
        __syncthreads();
        ConvDesc dn = d; const bool hn = it + stride < end;
        if (hn) { dn = conv_desc(p, list, it + stride); conv_load(r, dn); }
#pragma unroll
        for (int ps = 0; ps < 4; ++ps) { const int n = ps * 16 + (t >> 5), k8 = (t & 31) * 8; const unsigned* s = T + n * 129 + (k8 >> 1);
            u32x4 w; w.x = s[0]; w.y = s[1]; w.z = s[2]; w.w = s[3]; *(u32x4*)(d.dst + (size_t)(d.L0 + n) * d.Ktot + d.k0 + k8) = w; }
        __syncthreads();
        d = dn;
    }
}
DEVI void phase0(const Params& p, unsigned char* shm) {
    const int t = threadIdx.x;
    float* mod = (float*)(p.ws + OFF_MOD);
    {
        float* sc = (float*)shm; float* red = sc + 3072;
        for (int i = t; i < 3072; i += 512) { const int b = i >> 10, k = i & 1023; const float v = (b == 0) ? p.c_ctx[k] : p.c[(b - 1) * 1024 + k]; sc[i] = silu(v); }
        __syncthreads();
        for (int it = blockIdx.x; it < 144; it += gridDim.x) {
            const int n0 = it * 64, nq = t & 15, kg = t >> 4;
            f32x4 a0 = {0.f, 0.f, 0.f, 0.f}, a1 = a0, a2 = a0;
#pragma unroll 8
            for (int kk = 0; kk < 32; ++kk) { const int k = kg * 32 + kk; const f32x4 w = __builtin_nontemporal_load((const f32x4*)(p.w_mod + (size_t)k * 9216 + n0 + 4 * nq));
                a0 += sc[k] * w; a1 += sc[1024 + k] * w; a2 += sc[2048 + k] * w; }
            *(f32x4*)(red + (kg * 3 + 0) * 64 + 4 * nq) = a0; *(f32x4*)(red + (kg * 3 + 1) * 64 + 4 * nq) = a1; *(f32x4*)(red + (kg * 3 + 2) * 64 + 4 * nq) = a2;
            __syncthreads();
            if (t < 192) { const int b = t >> 6, n = t & 63; float s = 0.f;
#pragma unroll
                for (int g = 0; g < 32; ++g) s += red[(g * 3 + b) * 64 + n];
                mod[b * 9216 + n0 + n] = s + p.b_mod[n0 + n]; }
            __syncthreads();
        }
    }
    {
        float* binp = (float*)(p.ws + OFF_BINP);
        for (int i = blockIdx.x * 512 + t; i < 9216; i += gridDim.x * 512) binp[i] = p.b_in[win_src_col(i)];
    }
    if (gridDim.x == 256) {
        const int b = blockIdx.x;
        if (b >= 144) conv_items(p, shm, 0, b - 144, 224, 112); else if (b < 128) conv_items(p, shm, 0, 224 + b, 352, 128);
    } else conv_items(p, shm, 0, (int)blockIdx.x, 352, (int)gridDim.x);
}
DEVI void conv_rest(const Params& p, unsigned char* shm, int first, int stride) {
    for (int it = 352 + first; it < 1296; it += stride) {
        if (it < 528) conv_ffn(p.ffn1_w1, p.ffn1_w2, OFF_W1T, p, it, shm);
        else if (it < 1104) { const int i2 = it - 528, nb = i2 >> 2, kb = i2 & 3; conv_tile(p.w_in, 9232, win_src_col(64 * nb), (bf16_t*)(p.ws + OFF_WIN), 1024, 64 * nb, 256 * kb, shm); }
        else { const int i2 = it - 1104, mtx = i2 >> 6, i3 = i2 & 63, nb = i3 >> 2, kb = i3 & 3;
            const float* src = mtx == 0 ? p.w_ml_out : (mtx == 1 ? p.w_sc_out : p.w_o);
            bf16_t* dst = (bf16_t*)(p.ws + (mtx == 0 ? OFF_WML : (mtx == 1 ? OFF_WSC : OFF_WO)));
            conv_tile(src, 1024, 64 * nb, dst, 1024, 64 * nb, 256 * kb, shm); }
    }
}

template <int MODE> DEVI void row_phase(const Params& p, unsigned char* shm) {
    const int t = threadIdx.x, wid = t >> 6, lane = t & 63;
    const float* mod = (const float*)(p.ws + OFF_MOD);
    float* WgT = (float*)shm;
    if (MODE == 1) {
        {
            float wtmp[32];
#pragma unroll
            for (int j = 0; j < 32; ++j) { const int i = t + 512 * j, k = i >> 4, g = i & 15; wtmp[j] = p.w_in[(size_t)k * 9232 + 4096 + g]; }
#pragma unroll
            for (int j = 0; j < 32; ++j) { const int i = t + 512 * j, k = i >> 4, g = i & 15; WgT[g * 1024 + k] = wtmp[j]; } }
        __syncthreads();
    }
    const float* gvec = MODE == 3 ? p.final_norm : p.norm_g + MODE * 1024;
    bf16_t* hout = MODE == 2 ? zbuf(p, 7) : (bf16_t*)(p.out + (size_t)NTOK * 1024);
    float* gates = (float*)(p.ws + OFF_GATES);
    f32x4 gv[4];
#pragma unroll
    for (int i = 0; i < 4; ++i) gv[i] = *(const f32x4*)(gvec + i * 256 + 4 * lane);
    if (MODE == 1) {
        const int stride = gridDim.x * 8;
        for (int rowA = blockIdx.x * 8 + wid; rowA < NTOK; rowA += 2 * stride) {
            const int rowB = rowA + stride; const bool hasB = rowB < NTOK; const int rB = hasB ? rowB : rowA;
            f32x4 va[4], vb[4]; float ssa = 0.f, ssb = 0.f;
#pragma unroll
            for (int i = 0; i < 4; ++i) { va[i] = *(const f32x4*)(p.out + (size_t)rowA * 1024 + i * 256 + 4 * lane); vb[i] = *(const f32x4*)(p.out + (size_t)rB * 1024 + i * 256 + 4 * lane); }
            f32x4 sa[4], ha[4], sb[4], hb[4];
            { const float* sh = mod + cond_of_row(rowA) * 9216 + 3 * 1024; const float* sh2 = mod + cond_of_row(rB) * 9216 + 3 * 1024;
#pragma unroll
              for (int i = 0; i < 4; ++i) { ha[i] = *(const f32x4*)(sh + i * 256 + 4 * lane); sa[i] = *(const f32x4*)(sh + 1024 + i * 256 + 4 * lane); hb[i] = *(const f32x4*)(sh2 + i * 256 + 4 * lane); sb[i] = *(const f32x4*)(sh2 + 1024 + i * 256 + 4 * lane); } }
#pragma unroll
            for (int i = 0; i < 4; ++i) { ssa += va[i][0] * va[i][0] + va[i][1] * va[i][1] + va[i][2] * va[i][2] + va[i][3] * va[i][3]; ssb += vb[i][0] * vb[i][0] + vb[i][1] * vb[i][1] + vb[i][2] * vb[i][2] + vb[i][3] * vb[i][3]; }
            ssa = wave_sum(ssa); ssb = wave_sum(ssb);
            const float ra = rsqrtf(ssa * (1.f / 1024.f) + 1e-6f), rb = rsqrtf(ssb * (1.f / 1024.f) + 1e-6f);
#pragma unroll
            for (int i = 0; i < 4; ++i) { va[i] = va[i] * ra * gv[i] * (1.f + sa[i]) + ha[i]; vb[i] = vb[i] * rb * gv[i] * (1.f + sb[i]) + hb[i];
                u32x2 w; w.x = cvt_pk_bf16(va[i][0], va[i][1]); w.y = cvt_pk_bf16(va[i][2], va[i][3]); *(u32x2*)(hout + (size_t)rowA * 1024 + i * 256 + 4 * lane) = w;
                if (hasB) { u32x2 w2; w2.x = cvt_pk_bf16(vb[i][0], vb[i][1]); w2.y = cvt_pk_bf16(vb[i][2], vb[i][3]); *(u32x2*)(hout + (size_t)rowB * 1024 + i * 256 + 4 * lane) = w2; } }
            float pa[16], pb[16];
#pragma unroll
            for (int g = 0; g < 16; ++g) { float a = 0.f, b = 0.f;
#pragma unroll
                for (int i = 0; i < 4; ++i) { const f32x4 w4 = *(const f32x4*)(WgT + g * 1024 + i * 256 + 4 * lane);
                    a += va[i][0] * w4[0] + va[i][1] * w4[1] + va[i][2] * w4[2] + va[i][3] * w4[3]; b += vb[i][0] * w4[0] + vb[i][1] * w4[1] + vb[i][2] * w4[2] + vb[i][3] * w4[3]; }
                pa[g] = a; pb[g] = b; }
#define TRED(x, res) do { float b8[8], c4[4], d2[2]; bool up = (lane & 32) != 0; \
                _Pragma("unroll") for (int g = 0; g < 8; ++g) { const float snd = up ? x[g] : x[g + 8], kp = up ? x[g + 8] : x[g]; b8[g] = kp + __shfl_xor(snd, 32); } \
                up = (lane & 16) != 0; _Pragma("unroll") for (int g = 0; g < 4; ++g) { const float snd = up ? b8[g] : b8[g + 4], kp = up ? b8[g + 4] : b8[g]; c4[g] = kp + __shfl_xor(snd, 16); } \
                up = (lane & 8) != 0; _Pragma("unroll") for (int g = 0; g < 2; ++g) { const float snd = up ? c4[g] : c4[g + 2], kp = up ? c4[g + 2] : c4[g]; d2[g] = kp + __shfl_xor(snd, 8); } \
                up = (lane & 4) != 0; { const float snd = up ? d2[0] : d2[1], kp = up ? d2[1] : d2[0]; res = kp + __shfl_xor(snd, 4); } \
                res += __shfl_xor(res, 2); res += __shfl_xor(res, 1); } while (0)
            float ea, eb; TRED(pa, ea); TRED(pb, eb);
#undef TRED
            const int gidx = ((lane >> 5) & 1) * 8 + ((lane >> 4) & 1) * 4 + ((lane >> 3) & 1) * 2 + ((lane >> 2) & 1);
            if ((lane & 3) == 0) { const float bi = p.b_in[4096 + gidx]; gates[(size_t)rowA * 16 + gidx] = ea + bi; if (hasB) gates[(size_t)rowB * 16 + gidx] = eb + bi; }
        }
    } else
    for (int row = blockIdx.x * 8 + wid; row < NTOK; row += gridDim.x * 8) {
        const float* src = (MODE == 0) ? (row < NPR ? p.x_prompt + (size_t)row * 1024 : p.x_sample + (size_t)(row - NPR) * 1024) : p.out + (size_t)row * 1024;
        f32x4 v[4]; float ss = 0.f;
#pragma unroll
        for (int i = 0; i < 4; ++i) { v[i] = *(const f32x4*)(src + i * 256 + 4 * lane); ss += v[i][0] * v[i][0] + v[i][1] * v[i][1] + v[i][2] * v[i][2] + v[i][3] * v[i][3]; }
        ss = wave_sum(ss);
        const float rstd = rsqrtf(ss * (1.f / 1024.f) + 1e-6f);
        if (MODE == 3) {
#pragma unroll
            for (int i = 0; i < 4; ++i) *(f32x4*)(p.out + (size_t)row * 1024 + i * 256 + 4 * lane) = v[i] * rstd * gv[i];
        } else {
            const int b = cond_of_row(row);
            const float* sh = mod + b * 9216 + (MODE * 3) * 1024; const float* scl = sh + 1024;
            f32x4 s4v[4], h4v[4];
#pragma unroll
            for (int i = 0; i < 4; ++i) { s4v[i] = *(const f32x4*)(scl + i * 256 + 4 * lane); h4v[i] = *(const f32x4*)(sh + i * 256 + 4 * lane); }
#pragma unroll
            for (int i = 0; i < 4; ++i) { const f32x4 s4 = s4v[i], h4 = h4v[i];
                v[i] = v[i] * rstd * gv[i] * (1.f + s4) + h4;
                u32x2 w; w.x = cvt_pk_bf16(v[i][0], v[i][1]); w.y = cvt_pk_bf16(v[i][2], v[i][3]);
                *(u32x2*)(hout + (size_t)row * 1024 + i * 256 + 4 * lane) = w; }
            if (MODE == 1) {
                float my = 0.f;
#pragma unroll
                for (int g = 0; g < 16; ++g) { float a = 0.f;
#pragma unroll
                    for (int i = 0; i < 4; ++i) { const f32x4 w4 = *(const f32x4*)(WgT + g * 1024 + i * 256 + 4 * lane); a += v[i][0] * w4[0] + v[i][1] * w4[1] + v[i][2] * w4[2] + v[i][3] * w4[3]; }
                    a = wave_sum(a); if (lane == g) my = a; }
                if (lane < 16) gates[(size_t)row * 16 + lane] = my + p.b_in[4096 + lane];
            }
        }
    }
    __syncthreads();
}

struct EpiSwiglu {
    static constexpr bool PERM = true, AFTER_DRAIN = false; bf16_t* O;
    template <int MT> DEVI void operator()(const f32x4 (&acc)[2][2][MT][2], const Unit& u, int wr, int wc, int fr, int fq) const {
        const int row0 = u.pm * 64 * MT + wr * 16 * MT + fr, col0 = u.pn * 128 + wc * 32 + 8 * fq;
#pragma unroll
        for (int ai = 0; ai < 2; ++ai)
#pragma unroll
            for (int m = 0; m < MT; ++m) { bf16_t* rowp = O + (size_t)(row0 + ai * 32 * MT + m * 16) * 2816 + col0;
                float r[8];
#pragma unroll
                for (int n = 0; n < 2; ++n)
#pragma unroll
                    for (int j = 0; j < 4; ++j) r[4 * n + j] = silu(acc[ai][0][m][n][j]) * acc[ai][1][m][n][j];
                u32x4 w; w.x = cvt_pk_bf16(r[0], r[1]); w.y = cvt_pk_bf16(r[2], r[3]); w.z = cvt_pk_bf16(r[4], r[5]); w.w = cvt_pk_bf16(r[6], r[7]);
                *(u32x4*)rowp = w; }
    }
};
struct EpiResid {
    static constexpr bool PERM = false, AFTER_DRAIN = false; const float* xa; const float* xb; float* xo; const float* gate; float scale;
    template <int MT> DEVI void operator()(const f32x4 (&acc)[2][2][MT][2], const Unit& u, int wr, int wc, int fr, int fq) const {
        const int row0 = u.pm * 64 * MT + wr * 16 * MT + fr, col0 = u.pn * 256 + wc * 32 + 4 * fq;
        const int c_lo = cond_of_row(u.pm * 64 * MT), c_hi = cond_of_row(u.pm * 64 * MT + 64 * MT - 1);
        f32x4 g0[2][2], g1[2][2];
#pragma unroll
        for (int bj = 0; bj < 2; ++bj)
#pragma unroll
            for (int n = 0; n < 2; ++n) { g0[bj][n] = scale * *(const f32x4*)(gate + c_lo * 9216 + col0 + bj * 128 + n * 16); g1[bj][n] = scale * *(const f32x4*)(gate + c_hi * 9216 + col0 + bj * 128 + n * 16); }
#pragma unroll
        for (int ai = 0; ai < 2; ++ai) {
            f32x4 xv[MT][2][2];
#pragma unroll
            for (int m = 0; m < MT; ++m) { const int row = row0 + ai * 32 * MT + m * 16;
                const float* xi = (row < NPR) ? xa + (size_t)row * 1024 : xb + (size_t)(row - NPR) * 1024;
#pragma unroll
                for (int bj = 0; bj < 2; ++bj)
#pragma unroll
                    for (int n = 0; n < 2; ++n) xv[m][bj][n] = *(const f32x4*)(xi + col0 + bj * 128 + n * 16); }
#pragma unroll
            for (int m = 0; m < MT; ++m) { const int row = row0 + ai * 32 * MT + m * 16; float* xop = xo + (size_t)row * 1024; const bool hi = cond_of_row(row) != c_lo;
#pragma unroll
                for (int bj = 0; bj < 2; ++bj)
#pragma unroll
                    for (int n = 0; n < 2; ++n) { const f32x4 gv = hi ? g1[bj][n] : g0[bj][n]; *(f32x4*)(xop + col0 + bj * 128 + n * 16) = xv[m][bj][n] + gv * acc[ai][bj][m][n]; } }
        }
    }
};
struct EpiZ {
    static constexpr bool PERM = true, AFTER_DRAIN = false; unsigned char* zbase; const float* binp;
    template <int MT> DEVI void operator()(const f32x4 (&acc)[2][2][MT][2], const Unit& u, int wr, int wc, int fr, int fq) const {
        const int pn = u.pn, row0 = u.pm * 64 * MT + wr * 16 * MT + fr, cl = wc * 32 + 8 * fq;
        f32x4 bv[2][2];
#pragma unroll
        for (int bj = 0; bj < 2; ++bj)
#pragma unroll
            for (int n = 0; n < 2; ++n) bv[bj][n] = *(const f32x4*)(binp + pn * 256 + bj * 128 + cl + 4 * n);
        if (pn >= 20 && pn < 28) {
            bf16_t* O = (bf16_t*)(zbase + 5 * TB) + (pn - 20) * 128 + cl;
#pragma unroll
            for (int ai = 0; ai < 2; ++ai)
#pragma unroll
                for (int m = 0; m < MT; ++m) { float r[8];
#pragma unroll
                    for (int n = 0; n < 2; ++n)
#pragma unroll
                        for (int j = 0; j < 4; ++j) r[4 * n + j] = (acc[ai][0][m][n][j] + bv[0][n][j]) * (acc[ai][1][m][n][j] + bv[1][n][j]);
                    u32x4 w; w.x = cvt_pk_bf16(r[0], r[1]); w.y = cvt_pk_bf16(r[2], r[3]); w.z = cvt_pk_bf16(r[4], r[5]); w.w = cvt_pk_bf16(r[6], r[7]);
                    *(u32x4*)(O + (size_t)(row0 + ai * 32 * MT + m * 16) * 1024) = w; }
        } else {
            const int seg = pn < 20 ? (pn >> 2) : (pn < 32 ? 6 : 7);
            const int cb = pn < 20 ? (pn & 3) * 256 : ((pn - 28) & 3) * 256;
            const bool sg = (seg == 3) || (seg >= 6); const float mul = (seg == 1) ? 0.0625f : 1.f;
            bf16_t* O = (bf16_t*)(zbase + (size_t)seg * TB) + cb + cl;
#pragma unroll
            for (int ai = 0; ai < 2; ++ai)
#pragma unroll
                for (int m = 0; m < MT; ++m)
#pragma unroll
                    for (int bj = 0; bj < 2; ++bj) { float r[8];
#pragma unroll
                        for (int n = 0; n < 2; ++n)
#pragma unroll
                            for (int j = 0; j < 4; ++j) { float x = (acc[ai][bj][m][n][j] + bv[bj][n][j]) * mul; r[4 * n + j] = sg ? sigm(x) : x; }
                        u32x4 w; w.x = cvt_pk_bf16(r[0], r[1]); w.y = cvt_pk_bf16(r[2], r[3]); w.z = cvt_pk_bf16(r[4], r[5]); w.w = cvt_pk_bf16(r[6], r[7]);
                        *(u32x4*)(O + (size_t)(row0 + ai * 32 * MT + m * 16) * 1024 + bj * 128) = w; }
        }
    }
};
template <int SECOND> struct EpiY {
    static constexpr bool PERM = true, AFTER_DRAIN = false; const bf16_t* gate; bf16_t* Y;
    template <int MT> DEVI void operator()(const f32x4 (&acc)[2][2][MT][2], const Unit& u, int wr, int wc, int fr, int fq) const {
        const int row0 = u.pm * 64 * MT + wr * 16 * MT + fr, col0 = u.pn * 256 + wc * 32 + 8 * fq;
#pragma unroll
        for (int ai = 0; ai < 2; ++ai)
        { u32x4 gws[MT][2], yws[MT][2];
#pragma unroll
            for (int m = 0; m < MT; ++m)
#pragma unroll
                for (int bj = 0; bj < 2; ++bj) { const size_t off = (size_t)(row0 + ai * 32 * MT + m * 16) * 1024 + col0 + bj * 128; gws[m][bj] = *(const u32x4*)(gate + off); if (SECOND) yws[m][bj] = *(const u32x4*)(Y + off); }
#pragma unroll
            for (int m = 0; m < MT; ++m)
#pragma unroll
                for (int bj = 0; bj < 2; ++bj) { const size_t off = (size_t)(row0 + ai * 32 * MT + m * 16) * 1024 + col0 + bj * 128;
                    const u32x4 gw = gws[m][bj]; float r[8];
                    r[0] = bf_lo(gw.x) * acc[ai][bj][m][0][0]; r[1] = bf_hi(gw.x) * acc[ai][bj][m][0][1]; r[2] = bf_lo(gw.y) * acc[ai][bj][m][0][2]; r[3] = bf_hi(gw.y) * acc[ai][bj][m][0][3];
                    r[4] = bf_lo(gw.z) * acc[ai][bj][m][1][0]; r[5] = bf_hi(gw.z) * acc[ai][bj][m][1][1]; r[6] = bf_lo(gw.w) * acc[ai][bj][m][1][2]; r[7] = bf_hi(gw.w) * acc[ai][bj][m][1][3];
                    if (SECOND) { const u32x4 yw = yws[m][bj];
                        r[0] += bf_lo(yw.x); r[1] += bf_hi(yw.x); r[2] += bf_lo(yw.y); r[3] += bf_hi(yw.y); r[4] += bf_lo(yw.z); r[5] += bf_hi(yw.z); r[6] += bf_lo(yw.w); r[7] += bf_hi(yw.w); }
                    u32x4 w; w.x = cvt_pk_bf16(r[0], r[1]); w.y = cvt_pk_bf16(r[2], r[3]); w.z = cvt_pk_bf16(r[4], r[5]); w.w = cvt_pk_bf16(r[6], r[7]);
                    *(u32x4*)(Y + off) = w; } }
    }
};
template <int MT, class Epi> DEVI void run_gemm(const bf16_t* A, const bf16_t* Bt, int N, int K, const Epi& E, unsigned char* shm) {
    pg8::Gemm g; g.A = A; g.Bt = Bt; g.M = NTOK; g.N = N; g.K = K;
    pg8::StaticOrder S; S.init(NTOK, N, (int)gridDim.x, (int)blockIdx.x, 64 * MT);
    pg8::gemm_phase<Epi, pg8::StaticOrder, false, MT>((PG8_LAS unsigned char*)shm, g, S, E, nullptr);
    __syncthreads();
}

namespace ml {
constexpr int S_OFF = 0, A_OFF = 67584, B_OFF = 86016, T_BYTES = 33792, V_OFF = 153600;
template <int NP> DEVI void ld_nat(int tid, u32x4 (&r)[NP], const bf16_t* src, int ld) {
#pragma unroll
    for (int i = 0; i < NP; ++i) { const int idx = tid + 512 * i, row = idx >> 3, cp = idx & 7; r[i] = *(const u32x4*)(src + (size_t)row * ld + cp * 8); }
}
template <int NP> DEVI void st_nat(int tid, const u32x4 (&r)[NP], unsigned char* dst) {
#pragma unroll
    for (int i = 0; i < NP; ++i) { const int idx = tid + 512 * i, row = idx >> 3, cp = idx & 7; *(u32x4*)(dst + row * 144 + cp * 16) = r[i]; }
}
template <int NP> DEVI void ld_tr(int tid, u32x4 (&r)[NP], const bf16_t* src, int ld) {
    constexpr int PPR = NP * 8;
#pragma unroll
    for (int i = 0; i < NP; ++i) { const int idx = tid + 512 * i, kr = idx / PPR, cp = idx % PPR; r[i] = *(const u32x4*)(src + (size_t)kr * ld + cp * 8); }
}
template <int NP> DEVI void st_tr(int tid, const u32x4 (&r)[NP], unsigned char* T) {
    constexpr int PPR = NP * 8;
#pragma unroll
    for (int i = 0; i < NP; ++i) { const int idx = tid + 512 * i, kr = idx / PPR, cp = idx % PPR; *(u32x4*)(T + kr * 528 + cp * 16) = r[i]; }
}
typedef short v4i16 __attribute__((ext_vector_type(4)));
DEVI bf16x8 tr_frag(const unsigned char* T, int k0, int n0, int lane) {
    const int i = lane & 15, g = lane >> 4;
    const LAS v4i16* p = (const LAS v4i16*)(T + (k0 + 8 * g + (i >> 2)) * 528 + (n0 + 4 * (i & 3)) * 2);
    const v4i16 lo = __builtin_amdgcn_ds_read_tr16_b64_v4i16((LAS v4i16*)p), hi = __builtin_amdgcn_ds_read_tr16_b64_v4i16((LAS v4i16*)(p + 264));
    bf16x8 r; r[0] = lo[0]; r[1] = lo[1]; r[2] = lo[2]; r[3] = lo[3]; r[4] = hi[0]; r[5] = hi[1]; r[6] = hi[2]; r[7] = hi[3]; return r;
}
template <bool AT, bool BT> DEVI void mma_slab(f32x4 (&acc)[4][4], const unsigned char* Ab, int astride, const unsigned char* Bb, int wr, int wc, int lane) {
    const int fr = lane & 15, fq = lane >> 4;
#pragma unroll
    for (int ks = 0; ks < 2; ++ks) { bf16x8 a[4], b[4];
#pragma unroll
        for (int m = 0; m < 4; ++m) a[m] = AT ? tr_frag(Ab, 32 * ks, 64 * wr + 16 * m, lane) : *(const bf16x8*)(Ab + (64 * wr + 16 * m + fr) * astride + (32 * ks + 8 * fq) * 2);
#pragma unroll
        for (int n = 0; n < 4; ++n) b[n] = BT ? tr_frag(Bb, 32 * ks, 64 * wc + 16 * n, lane) : *(const bf16x8*)(Bb + (64 * wc + 16 * n + fr) * 144 + (32 * ks + 8 * fq) * 2);
#pragma unroll
        for (int m = 0; m < 4; ++m)
#pragma unroll
            for (int n = 0; n < 4; ++n) acc[m][n] = __builtin_amdgcn_mfma_f32_16x16x32_bf16(b[n], a[m], acc[m][n], 0, 0, 0); }
}
template <int AM, int BM, int DP> DEVI void bgemm(f32x4 (&acc)[4][4], unsigned char* shm, const bf16_t* Asrc, int lda, const bf16_t* Bsrc, int ldb, int nslab, int a_koff, const float* ascale) {
    u32x4 ra[DP][2], rb[DP][4];
    int t = threadIdx.x; asm volatile("" : "+v"(t));
    const int wid = t >> 6, lane = t & 63, wr = wid >> 2, wc = wid & 3;
    constexpr bool AG = (AM == 0 || AM == 3);
#define BG_LOAD(d, i) do { if (AG) ld_nat<2>(t, ra[d], Asrc + (i) * 64, lda); \
        if (BM == 0) ld_nat<4>(t, rb[d], Bsrc + (i) * 64, ldb); else ld_tr<4>(t, rb[d], Bsrc + (size_t)(i) * 64 * ldb, ldb); } while (0)
#pragma unroll
    for (int d = 0; d < DP; ++d) if (d < nslab) BG_LOAD(d, d);
#pragma unroll 1
    for (int i0 = 0; i0 < nslab; i0 += DP) {
#pragma unroll
        for (int d = 0; d < DP; ++d) { const int i = i0 + d;
            if (i < nslab) {
                unsigned char* Bb = shm + B_OFF + ((BM == 1) ? (i & 1) * T_BYTES : 0);
                if (AM == 0) st_nat<2>(t, ra[d], shm + A_OFF);
                if (AM == 3) {
#pragma unroll
                    for (int q = 0; q < 2; ++q) { const int idx = t + 512 * q, row = idx >> 3, cp = idx & 7; const float w = ascale[row]; const u32x4 x = ra[d][q]; u32x4 y;
                        y.x = cvt_pk_bf16(bf_lo(x.x) * w, bf_hi(x.x) * w); y.y = cvt_pk_bf16(bf_lo(x.y) * w, bf_hi(x.y) * w); y.z = cvt_pk_bf16(bf_lo(x.z) * w, bf_hi(x.z) * w); y.w = cvt_pk_bf16(bf_lo(x.w) * w, bf_hi(x.w) * w);
                        *(u32x4*)(shm + A_OFF + row * 144 + cp * 16) = y; } }
                if (BM == 0) st_nat<4>(t, rb[d], Bb); else st_tr<4>(t, rb[d], Bb);
                LBAR();
                if (i + DP < nslab) BG_LOAD(d, i + DP);
                mma_slab<false, BM == 1>(acc, (AM == 2) ? (shm + S_OFF + (a_koff + i * 64) * 2) : (shm + A_OFF), (AM == 2) ? 528 : 144, Bb, wr, wc, lane);
                if (AG || BM == 0) LBAR();
            } }
    }
#undef BG_LOAD
    if (AM == 2 && BM == 1) __syncthreads();
}
DEVI void zero_acc(f32x4 (&a)[4][4]) {
#pragma unroll
    for (int m = 0; m < 4; ++m)
#pragma unroll
        for (int n = 0; n < 4; ++n) a[m][n] = (f32x4){0.f, 0.f, 0.f, 0.f};
}
constexpr int TBL_OFF = 159744;
DEVI void chain_table(const Params& p, unsigned char* shm) {
    float* tbl = (float*)(shm + TBL_OFF); const int t = threadIdx.x;
    if (t < 16) { const int b = t >> 3, dh = t & 7, dir = dh >> 2, base = dh * 48 + 16 + b * 16;
        const float* bl = (const float*)(p.ws + OFF_BL) + base; const float* ml = (const float*)(p.ws + OFF_MLOC) + base;
        float blv[16], mlv[16];
#pragma unroll
        for (int s = 0; s < 16; ++s) { const int c = dir ? 15 - s : s; blv[s] = bl[c]; mlv[s] = ml[c]; }
        float m = p.state_m[b * 8 + dh];
#pragma unroll
        for (int s = 0; s < 16; ++s) { const int c = dir ? 15 - s : s; tbl[t * 16 + c] = m; m = fmaxf(blv[s] + m, mlv[s]); } }
    __syncthreads();
}
DEVI void chain_m(const Params& p, const unsigned char* shm, int cgk, int dh, float& m_in, float& m_out) {
    const float* tbl = (const float*)(shm + TBL_OFF);
    float m = 0.f;
    if (cgk >= 16) { const int lc = cgk - 16; m = tbl[((lc >> 4) * 8 + dh) * 16 + (lc & 15)]; }
    m_in = m; m_out = fmaxf(((const float*)(p.ws + OFF_BL))[dh * 48 + cgk] + m, ((const float*)(p.ws + OFF_MLOC))[dh * 48 + cgk]);
}
DEVI void m1_pair(const Params& p, int pair, unsigned char* shm) {
    float* sm = (float*)shm; const int t = threadIdx.x, lane = t & 63, wid = t >> 6, pos = t & 255, item = pair * 2 + (t >> 8);
    const int cgk = item >> 3, dh = item & 7, dir = dh >> 2, w4 = wid & 3, wb = wid & 4;
    const float* gates = (const float*)(p.ws + OFF_GATES);
    const int tok = cgk * 256 + (dir ? 255 - pos : pos);
    const float ii = gates[(size_t)tok * 16 + dh], f = gates[(size_t)tok * 16 + 8 + dh];
    float v = fminf(f, 0.f) - log1pf(expf(-fabsf(f)));
#pragma unroll
    for (int off = 1; off < 64; off <<= 1) { const float o = __shfl_up(v, off); if (lane >= off) v += o; }
    if (lane == 63) sm[wid] = v;
    __syncthreads();
    for (int k = 0; k < w4; ++k) v += sm[wb + k];
    const float b = v, gi = ii - b; float mx = gi;
#pragma unroll
    for (int off = 1; off < 64; off <<= 1) { const float o = __shfl_up(mx, off); if (lane >= off) mx = fmaxf(mx, o); }
    if (lane == 63) sm[8 + wid] = mx;
    __syncthreads();
    for (int k = 0; k < w4; ++k) mx = fmaxf(mx, sm[8 + wb + k]);
    ((float*)(p.ws + OFF_BQ))[dh * NTOK + tok] = b; ((float*)(p.ws + OFF_GI))[dh * NTOK + tok] = gi; ((float*)(p.ws + OFF_PMX))[dh * NTOK + tok] = mx;
    if (pos == 255) { ((float*)(p.ws + OFF_BL))[dh * 48 + cgk] = b; ((float*)(p.ws + OFF_MLOC))[dh * 48 + cgk] = b + mx; }
    __syncthreads();
}
DEVI void m2_item(const Params& p, int item, unsigned char* shm) {
    int t = threadIdx.x; asm volatile("" : "+v"(t));
    const int wid = t >> 6, lane = t & 63, wr = wid >> 2, wc = wid & 3, fr = lane & 15, fq = lane >> 4;
    const int cgk = item >> 4, dh = (item >> 1) & 7, half = item & 1, head = dh & 3, r0 = cgk * 256;
    float m_in, m_out; chain_m(p, shm, cgk, dh, m_in, m_out);
    float* vwk = (float*)(shm + V_OFF);
    const float blv = ((const float*)(p.ws + OFF_BL))[dh * 48 + cgk];
    if (t < 256) vwk[t] = __expf(blv + ((const float*)(p.ws + OFF_GI))[dh * NTOK + r0 + t] - m_out);
    __syncthreads();
    const bf16_t* kb = zbuf(p, 1) + (size_t)r0 * 1024 + head * 256 + 128 * half; const bf16_t* vb = zbuf(p, 2) + (size_t)r0 * 1024 + head * 256;
    f32x4 acc[4][4]; zero_acc(acc);
    float dn = 0.f;
    u32x4 ra[2], rb[4];
    ld_tr<2>(t, ra, kb, 1024); ld_tr<4>(t, rb, vb, 1024);
#pragma unroll 1
    for (int i = 0; i < 4; ++i) {
        unsigned char* Ta = shm + S_OFF + (i & 1) * T_BYTES; unsigned char* Tb = shm + B_OFF + (i & 1) * T_BYTES;
#pragma unroll
        for (int q = 0; q < 2; ++q) { const int idx = t + 512 * q, kr = idx >> 4, cp = idx & 15; const float w = vwk[i * 64 + kr]; u32x4 x = ra[q], y;
            y.x = cvt_pk_bf16(bf_lo(x.x) * w, bf_hi(x.x) * w); y.y = cvt_pk_bf16(bf_lo(x.y) * w, bf_hi(x.y) * w); y.z = cvt_pk_bf16(bf_lo(x.z) * w, bf_hi(x.z) * w); y.w = cvt_pk_bf16(bf_lo(x.w) * w, bf_hi(x.w) * w);
            *(u32x4*)(Ta + kr * 528 + cp * 16) = y; }
        st_tr<4>(t, rb, Tb);
        LBAR();
        if (i + 1 < 4) { ld_tr<2>(t, ra, kb + (size_t)(i + 1) * 64 * 1024, 1024); ld_tr<4>(t, rb, vb + (size_t)(i + 1) * 64 * 1024, 1024); }
        {
            unsigned short dv_[16];
#pragma unroll
            for (int j = 0; j < 16; ++j) dv_[j] = *(const unsigned short*)(Ta + ((t >> 7) * 16 + j) * 528 + 2 * (t & 127));
#pragma unroll
            for (int j = 0; j < 16; ++j) dn += bf2f(dv_[j]); }
        mma_slab<true, true>(acc, Ta, 0, Tb, wr, wc, lane);
    }
    { float* dred = vwk + 256; dred[t] = dn; __syncthreads();
      if (t < 128) { dn = dred[t] + dred[t + 128] + dred[t + 256] + dred[t + 384];
        if (cgk < 16) p.out[(size_t)NTOK * 1024 + (size_t)16 * 8 * 65536 + (cgk * 8 + dh) * 256 + 128 * half + t] = dn;
        else ((float*)(p.ws + OFF_DN))[(dh * 48 + cgk) * 256 + 128 * half + t] = dn; } }
    if (cgk < 16) {
        float* C = p.out + (size_t)NTOK * 1024 + (size_t)(cgk * 8 + dh) * 65536;
#pragma unroll
        for (int m = 0; m < 4; ++m)
#pragma unroll
            for (int n = 0; n < 4; ++n) *(f32x4*)(C + (128 * half + 64 * wr + 16 * m + fr) * 256 + 64 * wc + 16 * n + 4 * fq) = acc[m][n];
        if (half == 0 && t == 0) p.out[(size_t)NTOK * 1024 + (size_t)16 * 8 * 65536 + 16 * 8 * 256 + cgk * 8 + dh] = m_out;
    } else {
        bf16_t* C = (bf16_t*)(p.ws + OFF_CIN) + (size_t)(dh * 32 + (cgk - 16)) * 65536;
#pragma unroll
        for (int m = 0; m < 4; ++m)
#pragma unroll
            for (int n = 0; n < 4; ++n) { u32x2 w; w.x = cvt_pk_bf16(acc[m][n][0], acc[m][n][1]); w.y = cvt_pk_bf16(acc[m][n][2], acc[m][n][3]);
                *(u32x2*)(C + (128 * half + 64 * wr + 16 * m + fr) * 256 + 64 * wc + 16 * n + 4 * fq) = w; }
    }
    __syncthreads();
}
DEVI void m3_phase(const Params& p) {
    const int t = threadIdx.x;
    for (int it = blockIdx.x; it < 256; it += gridDim.x) {
        const int chain = it >> 4, seg = it & 15, b = chain >> 3, dh = chain & 7, dir = dh >> 2;
        const size_t e0 = (size_t)seg * 4096 + t * 8;
        const float* bl = (const float*)(p.ws + OFF_BL) + dh * 48 + 16 + b * 16; const float* mlc = (const float*)(p.ws + OFF_MLOC) + dh * 48 + 16 + b * 16;
        bf16_t* base = (bf16_t*)(p.ws + OFF_CIN) + (size_t)(dh * 32 + b * 16) * 65536 + e0;
        float* nbase = (float*)(p.ws + OFF_DN) + (dh * 48 + 16 + b * 16) * 256 + t;
        const bool do_n = (seg == 0 && t < 256);
        u32x4 dv[16]; float dnv[16];
#pragma unroll
        for (int c = 0; c < 16; ++c) { dv[c] = *(const u32x4*)(base + (size_t)c * 65536); dnv[c] = do_n ? nbase[c * 256] : 0.f; }
        float st[8]; { const f32x4 a = *(const f32x4*)(p.state_C + (size_t)(b * 8 + dh) * 65536 + e0), c = *(const f32x4*)(p.state_C + (size_t)(b * 8 + dh) * 65536 + e0 + 4);
            st[0] = a[0]; st[1] = a[1]; st[2] = a[2]; st[3] = a[3]; st[4] = c[0]; st[5] = c[1]; st[6] = c[2]; st[7] = c[3]; }
        float sn = do_n ? p.state_n[(b * 8 + dh) * 256 + t] : 0.f;
        float m = p.state_m[b * 8 + dh];
#pragma unroll
        for (int step = 0; step < 16; ++step) {
            const int cf = step, cb = 15 - step;
            const float blv = dir ? bl[cb] : bl[cf], mlv = dir ? mlc[cb] : mlc[cf];
            const float m_new = fmaxf(blv + m, mlv), decay = __expf(blv + m - m_new);
            const u32x4 d4 = dir ? dv[cb] : dv[cf]; const float dn1 = dir ? dnv[cb] : dnv[cf];
            u32x4 w; w.x = cvt_pk_bf16(st[0], st[1]); w.y = cvt_pk_bf16(st[2], st[3]); w.z = cvt_pk_bf16(st[4], st[5]); w.w = cvt_pk_bf16(st[6], st[7]);
            *(u32x4*)(base + (size_t)(dir ? cb : cf) * 65536) = w;
            st[0] = decay * st[0] + bf_lo(d4.x); st[1] = decay * st[1] + bf_hi(d4.x); st[2] = decay * st[2] + bf_lo(d4.y); st[3] = decay * st[3] + bf_hi(d4.y);
            st[4] = decay * st[4] + bf_lo(d4.z); st[5] = decay * st[5] + bf_hi(d4.z); st[6] = decay * st[6] + bf_lo(d4.w); st[7] = decay * st[7] + bf_hi(d4.w);
            if (do_n) { nbase[(dir ? cb : cf) * 256] = sn; sn = decay * sn + dn1; }
            m = m_new;
        }
    }
}
DEVI void conv_phase(const Params& p) {
    const bf16_t* u = zbuf(p, 5); bf16_t* bg = zbuf(p, 4);
    const int c8 = (threadIdx.x & 127) * 8, rsub = threadIdx.x >> 7;
    float w0[8], w1[8], w2[8], cb[8];
#pragma unroll
    for (int q = 0; q < 2; ++q) { const f32x4 a = *(const f32x4*)(p.conv_w + c8 + 4 * q), b = *(const f32x4*)(p.conv_w + 1024 + c8 + 4 * q), c = *(const f32x4*)(p.conv_w + 2048 + c8 + 4 * q), d = *(const f32x4*)(p.conv_b + c8 + 4 * q);
#pragma unroll
        for (int j = 0; j < 4; ++j) { w0[4 * q + j] = a[j]; w1[4 * q + j] = b[j]; w2[4 * q + j] = c[j]; cb[4 * q + j] = d[j]; } }
    for (int row = blockIdx.x * 4 + rsub; row < NTOK; row += gridDim.x * 4) {
        const int per = row < NPR ? 256 : 64, pos = row & (per - 1);
        const size_t o = (size_t)row * 1024 + c8;
        const u32x4 z4 = {0u, 0u, 0u, 0u};
        const u32x4 uc = *(const u32x4*)(u + o), um = pos > 0 ? *(const u32x4*)(u + o - 1024) : z4, up = pos < per - 1 ? *(const u32x4*)(u + o + 1024) : z4, bv = *(const u32x4*)(bg + o);
        float r[8];
#pragma unroll
        for (int q = 0; q < 4; ++q) {
            r[2 * q] = bf_lo(bv[q]) * (w0[2 * q] * bf_lo(um[q]) + w1[2 * q] * bf_lo(uc[q]) + w2[2 * q] * bf_lo(up[q]) + cb[2 * q]);
            r[2 * q + 1] = bf_hi(bv[q]) * (w0[2 * q + 1] * bf_hi(um[q]) + w1[2 * q + 1] * bf_hi(uc[q]) + w2[2 * q + 1] * bf_hi(up[q]) + cb[2 * q + 1]); }
        u32x4 w; w.x = cvt_pk_bf16(r[0], r[1]); w.y = cvt_pk_bf16(r[2], r[3]); w.z = cvt_pk_bf16(r[4], r[5]); w.w = cvt_pk_bf16(r[6], r[7]);
        *(u32x4*)(bg + o) = w;
    }
}
DEVI void out_item(const Params& p, int item, unsigned char* shm) {
    const int cgk = item >> 3, head = (item >> 1) & 3, half = item & 1, r0 = cgk * 256, t0 = r0 + 128 * half;
    const bool latent = cgk >= 16;
    const bf16_t* qb = zbuf(p, 0) + (size_t)t0 * 1024 + head * 256; bf16_t* omb = zbuf(p, 0) + (size_t)t0 * 1024 + head * 256;     const bf16_t* kb = zbuf(p, 1) + (size_t)r0 * 1024 + head * 256;
    const bf16_t* vb = zbuf(p, 2) + (size_t)r0 * 1024 + head * 256; const bf16_t* ob = zbuf(p, 3) + (size_t)t0 * 1024 + head * 256;
    float* vgi = (float*)(shm + V_OFF); float* vmx = vgi + 256; float* vwi = vmx + 128; float* vsc = vwi + 128; float* vmt = vsc + 128; float* vqn = vmt + 128; float* red = vqn + 128;
    f32x4 h[4][4]; zero_acc(h);
#pragma unroll 1
    for (int dir = 0; dir < 2; ++dir) {
        int t = threadIdx.x; asm volatile("" : "+v"(t));
        const int wid = t >> 6, lane = t & 63, wr = wid >> 2, wc = wid & 3, fr = lane & 15, fq = lane >> 4;
        const int dh = dir * 4 + head;
        float m_in, m_out; chain_m(p, shm, cgk, dh, m_in, m_out);
        if (t < 256) vgi[t] = ((const float*)(p.ws + OFF_GI))[dh * NTOK + r0 + t];
        if (t < 128) { const float pm = ((const float*)(p.ws + OFF_PMX))[dh * NTOK + t0 + t], mx = fmaxf(m_in, pm);
            vmx[t] = mx; vwi[t] = __expf(m_in - mx); vmt[t] = ((const float*)(p.ws + OFF_BQ))[dh * NTOK + t0 + t] + mx; }
        {
            const int row = t >> 2, part = t & 3; float qn = 0.f;
            if (latent) { const float* nin = (const float*)(p.ws + OFF_DN) + (dh * 48 + cgk) * 256 + 64 * part;
#pragma unroll
                for (int i = 0; i < 8; ++i) { const u32x4 w = *(const u32x4*)(qb + (size_t)row * 1024 + 64 * part + 8 * i); const f32x4 n0 = *(const f32x4*)(nin + 8 * i), n1 = *(const f32x4*)(nin + 8 * i + 4);
                    qn += bf_lo(w.x) * n0[0] + bf_hi(w.x) * n0[1] + bf_lo(w.y) * n0[2] + bf_hi(w.y) * n0[3] + bf_lo(w.z) * n1[0] + bf_hi(w.z) * n1[1] + bf_lo(w.w) * n1[2] + bf_hi(w.w) * n1[3]; } }
            qn += __shfl_xor(qn, 1); qn += __shfl_xor(qn, 2);
            if (part == 0) vqn[row] = qn;
        }
        __syncthreads();
        {
            f32x4 acc[4][4]; zero_acc(acc);
            bgemm<0, 0, 1>(acc, shm, qb, 1024, kb, 1024, 4, 0, nullptr);
#pragma unroll
            for (int m = 0; m < 4; ++m) { const int tl = 64 * wr + 16 * m + fr, tt = 128 * half + tl; const float mx = vmx[tl]; float rs = 0.f;
#pragma unroll
                for (int n = 0; n < 4; ++n) { const int s0 = 64 * wc + 16 * n + 4 * fq;
#pragma unroll
                    for (int j = 0; j < 4; ++j) { const int s = s0 + j; const bool valid = dir == 0 ? (s <= tt) : (s >= tt); const float w = valid ? acc[m][n][j] * __expf(vgi[s] - mx) : 0.f; acc[m][n][j] = w; rs += w; } }
                rs += __shfl_xor(rs, 16); rs += __shfl_xor(rs, 32);
                if (fq == 0) red[tl * 4 + wc] = rs; }
            __syncthreads();
#pragma unroll
            for (int m = 0; m < 4; ++m) { const int tl = 64 * wr + 16 * m + fr; const f32x4 rr = *(const f32x4*)(red + tl * 4); const float wi = vwi[tl];
                const float den = rr[0] + rr[1] + rr[2] + rr[3] + wi * vqn[tl], rd = 1.f / fmaxf(fabsf(den), __expf(-vmt[tl]));
                if (wc == 0 && fq == 0) vsc[tl] = wi * rd;
#pragma unroll
                for (int n = 0; n < 4; ++n) { const int s0 = 64 * wc + 16 * n + 4 * fq;
                    u32x2 w; w.x = cvt_pk_bf16(acc[m][n][0] * rd, acc[m][n][1] * rd); w.y = cvt_pk_bf16(acc[m][n][2] * rd, acc[m][n][3] * rd); *(u32x2*)(shm + S_OFF + tl * 528 + s0 * 2) = w; } }
        }
        __syncthreads();
        if (latent) bgemm<3, 1, 2>(h, shm, qb, 1024, (const bf16_t*)(p.ws + OFF_CIN) + (size_t)(dh * 32 + (cgk - 16)) * 65536, 256, 4, 0, vsc);
        const int s_lo = dir == 0 ? 0 : 2 * half, s_hi = dir == 0 ? 2 * (half + 1) : 4;
        bgemm<2, 1, 2>(h, shm, nullptr, 0, vb + (size_t)(64 * s_lo) * 1024, 1024, s_hi - s_lo, 64 * s_lo, nullptr);
    }
    int t = threadIdx.x; asm volatile("" : "+v"(t));
    const int wid = t >> 6, lane = t & 63, wr = wid >> 2, wc = wid & 3, fr = lane & 15, fq = lane >> 4;
    float ss[4];
#pragma unroll
    for (int m = 0; m < 4; ++m) { float a = 0.f;
#pragma unroll
        for (int n = 0; n < 4; ++n) a += h[m][n][0] * h[m][n][0] + h[m][n][1] * h[m][n][1] + h[m][n][2] * h[m][n][2] + h[m][n][3] * h[m][n][3];
        a += __shfl_xor(a, 16); a += __shfl_xor(a, 32); ss[m] = a; }
    if (fq == 0) {
#pragma unroll
        for (int m = 0; m < 4; ++m) red[(64 * wr + 16 * m + fr) * 4 + wc] = ss[m]; }
    __syncthreads();
    f32x4 mnv[4]; u32x2 owv[4][4];
#pragma unroll
    for (int n = 0; n < 4; ++n) mnv[n] = *(const f32x4*)(p.ml_norm + head * 256 + 64 * wc + 16 * n + 4 * fq);
#pragma unroll
    for (int m = 0; m < 4; ++m)
#pragma unroll
        for (int n = 0; n < 4; ++n) owv[m][n] = *(const u32x2*)(ob + (size_t)(64 * wr + 16 * m + fr) * 1024 + 64 * wc + 16 * n + 4 * fq);
#pragma unroll
    for (int m = 0; m < 4; ++m) { const int tl = 64 * wr + 16 * m + fr; const f32x4 rr = *(const f32x4*)(red + tl * 4);
        const float rstd = rsqrtf((rr[0] + rr[1] + rr[2] + rr[3]) * (1.f / 256.f) + 1e-6f);
#pragma unroll
        for (int n = 0; n < 4; ++n) { const int col = 64 * wc + 16 * n + 4 * fq; const f32x4 mn = mnv[n];
            const u32x2 ow = owv[m][n];
            u32x2 w; w.x = cvt_pk_bf16(h[m][n][0] * rstd * mn[0] * bf_lo(ow.x), h[m][n][1] * rstd * mn[1] * bf_hi(ow.x));
            w.y = cvt_pk_bf16(h[m][n][2] * rstd * mn[2] * bf_lo(ow.y), h[m][n][3] * rstd * mn[3] * bf_hi(ow.y));
            *(u32x2*)(omb + (size_t)tl * 1024 + col) = w; } }
    __syncthreads();
}
}

__global__ __launch_bounds__(512, 2) void mega(Params p) {
    extern __shared__ __attribute__((aligned(16))) unsigned char shm[];
    cg::grid_group grid = cg::this_grid();
    const int lo = p.phase_lo, hi = p.phase_hi, rm_ = p.rep_mask;
#ifndef REP_MASK
#define REP_MASK 0
#endif
#ifdef ONLY
#define PH(k) if ((k) == ONLY)
#else
#define PH(k) if (lo <= (k) && (k) < hi)
#endif
#define SYNC(k) if (lo <= (k) && (k) + 1 < hi) xcd_barrier(xbar)
    if (threadIdx.x < 4) ((LAS unsigned*)((LAS unsigned char*)shm + ST_OFF))[threadIdx.x] = 0u;
    __syncthreads();
    XcdBarrier xbar; xbar.bar = (unsigned*)(p.ws + OFF_BAR); xbar.x = 0; xbar.st = nullptr;
    if (hi > 100) grid.sync();
    if (hi - lo > 1) xbar = xcd_barrier_post((unsigned*)(p.ws + OFF_BAR), (volatile LAS unsigned*)((LAS unsigned char*)shm + ST_OFF));
    float* mod = (float*)(p.ws + OFF_MOD);
    bf16_t* hbuf = (bf16_t*)(p.out + (size_t)NTOK * 1024);
    bf16_t* act = (bf16_t*)(p.ws + OFF_Z);
    PH(0) { phase0(p, shm); }
    if (((REP_MASK >> 0) & 1) && ((rm_ >> 0) & 1)) PH(0) { phase0(p, shm); }
    SYNC(0);
    PH(1) { row_phase<0>(p, shm); }
    if (((REP_MASK >> 1) & 1) && ((rm_ >> 1) & 1)) PH(1) { row_phase<0>(p, shm); }
    SYNC(1);
    PH(2) { { EpiSwiglu E; E.O = act; run_gemm<4>(hbuf, (const bf16_t*)(p.ws + OFF_W1T), 5632, 1024, E, shm); if (gridDim.x > 64) { if (blockIdx.x >= 32) conv_items(p, shm, 0, 352 + (int)blockIdx.x - 32, 1296, (int)gridDim.x - 32); } else conv_items(p, shm, 0, 352 + (int)blockIdx.x, 1296, (int)gridDim.x);
        if (gridDim.x == 256 && blockIdx.x >= 32 && blockIdx.x < 176) conv_items(p, shm, 1, 384 + (int)blockIdx.x - 32, 528, 1 << 20); } }
    if (((REP_MASK >> 2) & 1) && ((rm_ >> 2) & 1)) PH(2) { { EpiSwiglu E; E.O = act; run_gemm<4>(hbuf, (const bf16_t*)(p.ws + OFF_W1T), 5632, 1024, E, shm); if (gridDim.x > 64) { if (blockIdx.x >= 32) conv_items(p, shm, 0, 352 + (int)blockIdx.x - 32, 1296, (int)gridDim.x - 32); } else conv_items(p, shm, 0, 352 + (int)blockIdx.x, 1296, (int)gridDim.x); } }
    SYNC(2);
    PH(3) { { EpiResid E; E.xa = p.x_prompt; E.xb = p.x_sample; E.xo = p.out; E.gate = mod + 2 * 1024; E.scale = 0.5f; run_gemm<GMT>(act, (const bf16_t*)(p.ws + OFF_W2T), 1024, 2816, E, shm); } }
    if (((REP_MASK >> 3) & 1) && ((rm_ >> 3) & 1)) PH(3) { { EpiResid E; E.xa = p.x_prompt; E.xb = p.x_sample; E.xo = p.out; E.gate = mod + 2 * 1024; E.scale = 0.5f; run_gemm<GMT>(act, (const bf16_t*)(p.ws + OFF_W2T), 1024, 2816, E, shm); } }
    SYNC(3);
    PH(4) { row_phase<1>(p, shm); }
    if (((REP_MASK >> 4) & 1) && ((rm_ >> 4) & 1)) PH(4) { row_phase<1>(p, shm); }
    SYNC(4);
    PH(5) { {
        if (gridDim.x == 256) { if (blockIdx.x >= 192) for (int it = (int)blockIdx.x - 192; it < 192; it += 64) ml::m1_pair(p, it, shm); }
        else for (int it = blockIdx.x; it < 192; it += gridDim.x) ml::m1_pair(p, it, shm);
        __syncthreads();
        EpiZ E; E.zbase = p.ws + OFF_Z; E.binp = (const float*)(p.ws + OFF_BINP); run_gemm<4>(hbuf, (const bf16_t*)(p.ws + OFF_WIN), 9216, 1024, E, shm);
        if (gridDim.x == 256 && blockIdx.x >= 192) conv_items(p, shm, 1, (int)blockIdx.x - 192, 256, 64);
    } }
    if (((REP_MASK >> 5) & 1) && ((rm_ >> 5) & 1)) PH(5) { {
        if (gridDim.x == 256) { if (blockIdx.x >= 192) for (int it = (int)blockIdx.x - 192; it < 192; it += 64) ml::m1_pair(p, it, shm); }
        else for (int it = blockIdx.x; it < 192; it += gridDim.x) ml::m1_pair(p, it, shm);
        __syncthreads();
        EpiZ E; E.zbase = p.ws + OFF_Z; E.binp = (const float*)(p.ws + OFF_BINP); run_gemm<4>(hbuf, (const bf16_t*)(p.ws + OFF_WIN), 9216, 1024, E, shm);
    } }
    SYNC(5);
    PH(6) { { ml::chain_table(p, shm);
        if (gridDim.x == 256) { const int b = blockIdx.x;
            if (b >= 128) { const int c = b - 128; ml::out_item(p, 2 * ((c & 7) * 8 + (c >> 4)) + ((c >> 3) & 1), shm); ml::m2_item(p, 640 + c, shm); conv_items(p, shm, 1, 256 + c, 384, 1 << 20); }
            else { for (int k = 0; k < 5; ++k) ml::m2_item(p, b + 128 * k, shm); } }
        else for (int it = blockIdx.x; it < 768; it += gridDim.x) ml::m2_item(p, it, shm); ml::conv_phase(p); } }
    if (((REP_MASK >> 6) & 1) && ((rm_ >> 6) & 1)) PH(6) { { ml::chain_table(p, shm);
        if (gridDim.x == 256) { const int b = blockIdx.x;
            for (int r = 0; r < 3; ++r) { const int group = r * 64 + (b & 7) * 8 + (b >> 5), member = (b >> 3) & 3, cgk = group >> 2, head = group & 3, dh = (member >> 1) * 4 + head; ml::m2_item(p, cgk * 16 + dh * 2 + (member & 1), shm); } }
        else for (int it = blockIdx.x; it < 768; it += gridDim.x) ml::m2_item(p, it, shm);  } }
    SYNC(6);
    PH(7) { ml::m3_phase(p); }
    if (((REP_MASK >> 7) & 1) && ((rm_ >> 7) & 1)) PH(7) { ml::m3_phase(p); }
    SYNC(7);
    PH(8) { { ml::chain_table(p, shm);
        if (gridDim.x == 256) { const int b = blockIdx.x;
            ml::out_item(p, 128 + 2 * ((b & 7) * 16 + (b >> 4)) + ((b >> 3) & 1), shm); }
        else for (int it = (int)gridDim.x - 1 - (int)blockIdx.x + 0; it < 384; it += gridDim.x) ml::out_item(p, 383 - it, shm);
        if (gridDim.x != 256) conv_items(p, shm, 1, (int)blockIdx.x, 528, (int)gridDim.x); } }
    if (((REP_MASK >> 8) & 1) && ((rm_ >> 8) & 1)) PH(8) { { ml::chain_table(p, shm);
        if (gridDim.x == 256) { const int b = blockIdx.x;
            ml::out_item(p, 128 + 2 * ((b & 7) * 16 + (b >> 4)) + ((b >> 3) & 1), shm);
            if (b >= 128) { const int c = b - 128; ml::out_item(p, 2 * ((c & 7) * 8 + (c >> 4)) + ((c >> 3) & 1), shm); } }
        else for (int it = (int)gridDim.x - 1 - (int)blockIdx.x + 0; it < 384; it += gridDim.x) ml::out_item(p, 383 - it, shm);
        if (gridDim.x == 256) { if (blockIdx.x < 128) conv_items(p, shm, 1, (int)blockIdx.x, 528, 128); }
        else conv_items(p, shm, 1, (int)blockIdx.x, 528, (int)gridDim.x); } }
    SYNC(8);
    PH(9) { {
        { EpiY<0> E; E.gate = zbuf(p, 6); E.Y = zbuf(p, 1); run_gemm<GMT>(zbuf(p, 0), (const bf16_t*)(p.ws + OFF_WML), 1024, 1024, E, shm); }
        { EpiY<1> E; E.gate = zbuf(p, 7); E.Y = zbuf(p, 1); run_gemm<GMT>(zbuf(p, 4), (const bf16_t*)(p.ws + OFF_WSC), 1024, 1024, E, shm); }
    } }
    if (((REP_MASK >> 9) & 1) && ((rm_ >> 9) & 1)) PH(9) { {
        { EpiY<0> E; E.gate = zbuf(p, 6); E.Y = zbuf(p, 1); run_gemm<GMT>(zbuf(p, 0), (const bf16_t*)(p.ws + OFF_WML), 1024, 1024, E, shm); }
        { EpiY<1> E; E.gate = zbuf(p, 7); E.Y = zbuf(p, 1); run_gemm<GMT>(zbuf(p, 4), (const bf16_t*)(p.ws + OFF_WSC), 1024, 1024, E, shm); }
    } }
    SYNC(9);
    PH(10) { {
        EpiResid E; E.xa = p.out; E.xb = p.out + (size_t)NPR * 1024; E.xo = p.out; E.gate = mod + 5 * 1024; E.scale = 1.0f; run_gemm<GMT>(zbuf(p, 1), (const bf16_t*)(p.ws + OFF_WO), 1024, 1024, E, shm);
    } }
    if (((REP_MASK >> 10) & 1) && ((rm_ >> 10) & 1)) PH(10) { {
        EpiResid E; E.xa = p.out; E.xb = p.out + (size_t)NPR * 1024; E.xo = p.out; E.gate = mod + 5 * 1024; E.scale = 1.0f; run_gemm<GMT>(zbuf(p, 1), (const bf16_t*)(p.ws + OFF_WO), 1024, 1024, E, shm);
    } }
    SYNC(10);
    PH(11) { row_phase<2>(p, shm); }
    if (((REP_MASK >> 11) & 1) && ((rm_ >> 11) & 1)) PH(11) { row_phase<2>(p, shm); }
    SYNC(11);
    PH(12) { { EpiSwiglu E; E.O = act; run_gemm<4>(zbuf(p, 7), (const bf16_t*)(p.ws + OFF_F2), 5632, 1024, E, shm); } }
    if (((REP_MASK >> 12) & 1) && ((rm_ >> 12) & 1)) PH(12) { { EpiSwiglu E; E.O = act; run_gemm<4>(zbuf(p, 7), (const bf16_t*)(p.ws + OFF_F2), 5632, 1024, E, shm); } }
    SYNC(12);
    PH(13) { { EpiResid E; E.xa = p.out; E.xb = p.out + (size_t)NPR * 1024; E.xo = p.out; E.gate = mod + 8 * 1024; E.scale = 0.5f; run_gemm<GMT>(act, (const bf16_t*)(p.ws + OFF_F2 + 11 * MiB), 1024, 2816, E, shm); } }
    if (((REP_MASK >> 13) & 1) && ((rm_ >> 13) & 1)) PH(13) { { EpiResid E; E.xa = p.out; E.xb = p.out + (size_t)NPR * 1024; E.xo = p.out; E.gate = mod + 8 * 1024; E.scale = 0.5f; run_gemm<GMT>(act, (const bf16_t*)(p.ws + OFF_F2 + 11 * MiB), 1024, 2816, E, shm); } }
    SYNC(13);
    PH(14) row_phase<3>(p, shm);
}

extern "C" void kernel_launch(void* const* d_in, const int* in_sizes, int n_in, void* d_out, int out_size, void* d_ws, size_t ws_size, hipStream_t stream) {
    static int grid_blocks = 0;
    if (!grid_blocks) {
        int dev = 0, cus = 0, per_cu = 0;
        hipGetDevice(&dev);
        hipDeviceGetAttribute(&cus, hipDeviceAttributeMultiprocessorCount, dev);
        hipFuncSetAttribute((const void*)mega, hipFuncAttributeMaxDynamicSharedMemorySize, LDS_BYTES);
        hipOccupancyMaxActiveBlocksPerMultiprocessor(&per_cu, mega, 512, LDS_BYTES);
        if (per_cu < 1) { fprintf(stderr, "occupancy query returned %d\n", per_cu); per_cu = 1; }
        grid_blocks = cus * per_cu;
    }
    Params p{};
    const float** f = (const float**)&p;
    for (int i = 0; i < 23; ++i) f[i] = (const float*)d_in[i];
    p.out = (float*)d_out; p.ws = (unsigned char*)d_ws; p.rep_mask = REP_MASK;
#if COOP
    (void)hipMemsetAsync((unsigned char*)d_ws + OFF_BAR, 0, XCD_BAR_WORDS * 4, stream);
    p.phase_lo = 0; p.phase_hi = 15;
    void* args[] = {&p};
    hipError_t e = hipLaunchCooperativeKernel((void*)mega, dim3(grid_blocks), dim3(512), args, LDS_BYTES, stream);
    if (e != hipSuccess) fprintf(stderr, "cooperative launch failed: %s (grid %d)\n", hipGetErrorString(e), grid_blocks);
#else
    for (int ph = 0; ph < 15; ++ph) { p.phase_lo = ph; p.phase_hi = ph + 1; hipLaunchKernelGGL(mega, dim3(grid_blocks), dim3(512), LDS_BYTES, stream, p); }
#endif
}
```

```cpp
#include <hip/hip_runtime.h>
#include <hip/hip_cooperative_groups.h>
#include <cstdio>
namespace cg = cooperative_groups;
namespace pg8 {
#define PG8_LAS __attribute__((address_space(3)))
typedef unsigned short bf16_t;
typedef short bf16x8 __attribute__((ext_vector_type(8)));
typedef float f32x4 __attribute__((ext_vector_type(4)));
typedef unsigned u32x4 __attribute__((ext_vector_type(4)));
constexpr int BM = 256, BK = 64, HALF = 128, HTB = HALF * BK * 2  , STAGE_BYTES = 8 * HTB, NXCD = 8, WGM = 8;

__host__ __device__ __forceinline__ int lds_byte(int r, int c) { const int st = (r >> 4) * 2 + (c >> 5), rr = r & 15, cc = c & 31, ob = rr * 64 + cc * 2; return st * 1024 + (ob ^ (((ob >> 9) & 1) << 5)); }
__host__ __device__ __forceinline__ void stage_rc(int b, int& R, int& C) { const int st = b / 1024, sb = b % 1024, swz = sb ^ (((sb >> 9) & 1) << 5); R = (st >> 1) * 16 + swz / 64; C = (st & 1) * 32 + (swz % 64) / 2; }
__host__ __device__ __forceinline__ int perm32(int rho) { const int n = rho >> 4, i = rho & 15; return 8 * (i >> 2) + 4 * n + (i & 3); }

struct Unit { int pm, pn; };
struct Gemm { const bf16_t* A; const bf16_t* Bt; int M, N, K; };
struct StaticOrder {
    int nM, nN, nwg, G, c;
    __host__ __device__ void init(int M, int N, int G_, int c_, int rows = BM) { nM = M / rows; nN = N / BM; nwg = nM * nN; G = G_; c = c_; }
    __host__ __device__ bool next(int i, Unit& u) const {
        const long L = (long)i * G + c; if (L >= nwg) return false;
        int wgid = (int)L; { const int q = nwg / NXCD, r = nwg % NXCD, xcd = wgid % NXCD, off = wgid / NXCD; wgid = (xcd < r ? xcd * (q + 1) : r * (q + 1) + (xcd - r) * q) + off; }
        const int nig = WGM * nN, gid = wgid / nig, fm = gid * WGM, gsz = (nM - fm) < WGM ? (nM - fm) : WGM;
        u.pm = fm + ((wgid % nig) % gsz); u.pn = (wgid % nig) / gsz; return true;
    }
    __device__ __forceinline__ void a_ready(const Unit&) const {}
    __device__ __forceinline__ void done(const Unit&) const {}
};
__device__ __forceinline__ unsigned cvt_pk_bf16(float lo, float hi) { unsigned r; asm volatile("v_cvt_pk_bf16_f32 %0, %1, %2" : "=v"(r) : "v"(lo), "v"(hi)); return r; }
template <class Epi, class Sched, bool STAMP = false, int MT = 4>
__device__ __forceinline__ void gemm_phase(PG8_LAS unsigned char* lds, const Gemm g, const Sched& S, const Epi& E, unsigned long long* stamps) {
    const int tid = threadIdx.x, wid = __builtin_amdgcn_readfirstlane(tid >> 6), lane = tid & 63, wr = wid >> 2, wc = wid & 3, fr = lane & 15, fq = lane >> 4;
    const int K = g.K, nt = K / BK;
    int ts_lo = 0, ts_hi = 0, nts = 0; const unsigned long long rt_entry = STAMP ? (unsigned long long)wall_clock64() : 0ull;
#define PG8_STAMP() do { if (STAMP && wid == 0 && nts < 64) { const unsigned long long _c = (unsigned long long)clock64(); \
        ts_lo = (lane == nts) ? (int)(unsigned)_c : ts_lo; ts_hi = (lane == nts) ? (int)(unsigned)(_c >> 32) : ts_hi; ++nts; } } while (0)
    PG8_STAMP();
    unsigned voffA[2], voffB[2];
#pragma unroll
    for (int i = 0; i < 2; ++i) { int R, C; stage_rc(tid * 16 + i * 8192, R, C); const int Rb = Epi::PERM ? ((R & ~31) + perm32(R & 31)) : R;
        voffA[i] = (unsigned)(R * K + C) * 2u; voffB[i] = (unsigned)(Rb * K + C) * 2u; }
    const size_t kstep = (size_t)(BK * 2);
    const size_t hstep = (size_t)HALF * K * 2;
    const size_t tstep = 2 * hstep; const size_t hstepA = (size_t)(32 * MT) * K * 2, tstepA = 2 * hstepA;
    const unsigned ldsw = (unsigned)wid * 1024u;
    const int aoff = lds_byte(wr * 16 * MT + fr, fq * 8), boff = lds_byte(wc * 32 + fr, fq * 8);
#define PG8_SA(b, h) (((b) * 2 + (h)) * HTB)
#define PG8_SB(b, h) ((4 + (b) * 2 + (h)) * HTB)
#define PG8_STAGE(bufoff, gbase, voff) do { _Pragma("unroll") for (int _i = 0; _i < 2; ++_i) \
        __builtin_amdgcn_global_load_lds((const unsigned*)((const char*)(gbase) + (voff)[_i]), (PG8_LAS unsigned*)(lds + (bufoff) + ldsw + _i * 8192), 16, 0, 0); } while (0)
#define PG8_LDA(dst, b, h) do { _Pragma("unroll") for (int m = 0; m < MT; ++m) _Pragma("unroll") for (int k = 0; k < 2; ++k) dst[m][k] = *(const PG8_LAS bf16x8*)(lds + PG8_SA(b, h) + aoff + m * 2048 + k * 1024); } while (0)
#define PG8_LDB(dst, b, h) do { _Pragma("unroll") for (int n = 0; n < 2; ++n) _Pragma("unroll") for (int k = 0; k < 2; ++k) dst[n][k] = *(const PG8_LAS bf16x8*)(lds + PG8_SB(b, h) + boff + n * 2048 + k * 1024); } while (0)
#define PG8_MMA(ai, bj, At, Bt) do { __builtin_amdgcn_s_setprio(1); _Pragma("unroll") for (int m = 0; m < MT; ++m) _Pragma("unroll") for (int n = 0; n < 2; ++n) _Pragma("unroll") for (int k = 0; k < 2; ++k) \
        acc[ai][bj][m][n] = __builtin_amdgcn_mfma_f32_16x16x32_bf16(Bt[n][k], At[m][k], acc[ai][bj][m][n], 0, 0, 0); __builtin_amdgcn_s_setprio(0); } while (0)
#define PG8_WAIT_V(n) asm volatile("s_waitcnt vmcnt(" #n ")" ::: "memory")
#define PG8_WAIT_L(n) asm volatile("s_waitcnt lgkmcnt(" #n ")" ::: "memory")
#define PG8_BAR __builtin_amdgcn_s_barrier()
#define PG8_SCHED __builtin_amdgcn_sched_barrier(0)
    Unit cur, nxt; int ui = 0;
    if (!S.next(0, cur)) return;
    f32x4 acc[2][2][MT][2];
#pragma unroll
    for (int a = 0; a < 2; ++a)
#pragma unroll
        for (int b = 0; b < 2; ++b)
#pragma unroll
            for (int m = 0; m < MT; ++m)
#pragma unroll
                for (int n = 0; n < 2; ++n) acc[a][b][m][n] = (f32x4){0.f, 0.f, 0.f, 0.f};
    bf16x8 At[MT][2], B0[2][2], B1[2][2];
    const char* cA = (const char*)g.A + (size_t)cur.pm * tstepA; const char* cB = (const char*)g.Bt + (size_t)cur.pn * tstep;
    S.a_ready(cur);
    PG8_STAGE(PG8_SB(0, 0), cB, voffB); PG8_STAGE(PG8_SA(0, 0), cA, voffA); PG8_STAGE(PG8_SB(0, 1), cB + hstep, voffB); PG8_STAGE(PG8_SA(0, 1), cA + hstepA, voffA);
    if (wr == 1) PG8_BAR;
    PG8_WAIT_V(4); PG8_BAR;
    PG8_STAGE(PG8_SB(1, 0), cB + kstep, voffB); PG8_STAGE(PG8_SA(1, 0), cA + kstep, voffA); PG8_STAGE(PG8_SB(1, 1), cB + hstep + kstep, voffB);
    PG8_WAIT_V(6); PG8_BAR;
    PG8_STAMP();
    for (;;) {
        const bool has_next = S.next(ui + 1, nxt);
        const char* nA = has_next ? (const char*)g.A + (size_t)nxt.pm * tstepA : cA; const char* nB = has_next ? (const char*)g.Bt + (size_t)nxt.pn * tstep : cB;
        for (int t = 0; t < nt; t += 2) {
            const bool last = (t == nt - 2);
            const char* a1 = cA + (size_t)(t + 1) * kstep;
            const char* a2 = last ? nA : cA + (size_t)(t + 2) * kstep; const char* b2 = last ? nB : cB + (size_t)(t + 2) * kstep;
            const char* a3 = a2 + kstep; const char* b3 = b2 + kstep;
            if (last && has_next) S.a_ready(nxt);
            PG8_LDB(B0, 0, 0); PG8_SCHED; PG8_LDA(At, 0, 0); PG8_STAGE(PG8_SA(1, 1), a1 + hstepA, voffA);
            if constexpr (MT == 4) PG8_WAIT_L(8); else PG8_WAIT_L(6); PG8_BAR; PG8_WAIT_L(0); PG8_MMA(0, 0, At, B0); PG8_BAR; PG8_SCHED;
            PG8_LDB(B1, 0, 1); PG8_STAGE(PG8_SB(0, 0), b2, voffB);
            PG8_BAR; PG8_WAIT_L(0); PG8_MMA(0, 1, At, B1); PG8_BAR;
            PG8_LDA(At, 0, 1); PG8_STAGE(PG8_SA(0, 0), a2, voffA);
            PG8_BAR; PG8_WAIT_L(0); PG8_MMA(1, 0, At, B0); PG8_BAR; PG8_SCHED;
            PG8_STAGE(PG8_SB(0, 1), b2 + hstep, voffB);
            PG8_WAIT_V(6); PG8_BAR; PG8_MMA(1, 1, At, B1); PG8_BAR;
            PG8_LDB(B0, 1, 0); PG8_SCHED; PG8_LDA(At, 1, 0); PG8_STAGE(PG8_SA(0, 1), a2 + hstepA, voffA);
            if constexpr (MT == 4) PG8_WAIT_L(8); else PG8_WAIT_L(6); PG8_BAR; PG8_WAIT_L(0); PG8_MMA(0, 0, At, B0); PG8_BAR; PG8_SCHED;
            PG8_LDB(B1, 1, 1); PG8_STAGE(PG8_SB(1, 0), b3, voffB);
            PG8_BAR; PG8_WAIT_L(0); PG8_MMA(0, 1, At, B1); PG8_BAR;
            PG8_LDA(At, 1, 1); PG8_STAGE(PG8_SA(1, 0), a3, voffA);
            PG8_BAR; PG8_WAIT_L(0); PG8_MMA(1, 0, At, B0); PG8_BAR; PG8_SCHED;
            PG8_STAGE(PG8_SB(1, 1), b3 + hstep, voffB);
            PG8_WAIT_V(6); PG8_BAR; PG8_MMA(1, 1, At, B1); PG8_BAR;
        }
        PG8_STAMP();
        if constexpr (!Epi::AFTER_DRAIN) { E(acc, cur, wr, wc, fr, fq); S.done(cur); }
        PG8_STAMP();
        if (!has_next) break;
#pragma unroll
        for (int a = 0; a < 2; ++a)
#pragma unroll
            for (int b = 0; b < 2; ++b)
#pragma unroll
                for (int m = 0; m < MT; ++m)
#pragma unroll
                    for (int n = 0; n < 2; ++n) acc[a][b][m][n] = (f32x4){0.f, 0.f, 0.f, 0.f};
        cur = nxt; cA = nA; cB = nB; ++ui;
    }
    PG8_WAIT_V(0);
    if (wr == 0) PG8_BAR;
    PG8_BAR;
    if constexpr (Epi::AFTER_DRAIN) { E.fused(acc, cur, wr, wc, fr, fq, lds, wid, lane); S.done(cur); }
    PG8_STAMP();
    if (STAMP && wid == 0) { stamps[lane] = lane < nts ? (((unsigned long long)(unsigned)ts_hi << 32) | (unsigned)ts_lo) : 0ull;
        if (lane == 62) stamps[62] = rt_entry; if (lane == 63) stamps[63] = (unsigned long long)wall_clock64(); }
#undef PG8_STAMP
#undef PG8_SA
#undef PG8_SB
#undef PG8_STAGE
#undef PG8_LDA
#undef PG8_LDB
#undef PG8_MMA
#undef PG8_WAIT_V
#undef PG8_WAIT_L
#undef PG8_BAR
#undef PG8_SCHED
}
}
using pg8::bf16_t; using pg8::bf16x8; using pg8::f32x4; using pg8::u32x4; using pg8::cvt_pk_bf16; using pg8::Unit;
typedef unsigned u32x2 __attribute__((ext_vector_type(2)));
#define DEVI __device__ __forceinline__
#define LBAR() do { asm volatile("s_waitcnt lgkmcnt(0)" ::: "memory"); __builtin_amdgcn_s_barrier(); asm volatile("" ::: "memory"); } while (0)
#define LAS __attribute__((address_space(3)))
#define XB_TMO      128
#define XB_XCNT(j)  (256  + 64 * (j))
#define XB_XSUB(j)  (1280 + 64 * (j))
#define XB_XGEN(j)  (2304 + 64 * (j))
#define XB_TOP      3328
#define XB_TOPGEN   3392
#define XCD_BAR_WORDS 3456
#define XB_SPIN_CAP (1u << 18)

__device__ __forceinline__ unsigned xb_ld(unsigned* p)              { return __hip_atomic_load(p, __ATOMIC_RELAXED, __HIP_MEMORY_SCOPE_AGENT); }
__device__ __forceinline__ unsigned xb_add(unsigned* p, unsigned v) { return __hip_atomic_fetch_add(p, v, __ATOMIC_RELAXED, __HIP_MEMORY_SCOPE_AGENT); }
__device__ __forceinline__ unsigned xb_xcc_id() { return (unsigned)__builtin_amdgcn_s_getreg((3 << 11) | 20) & 0xFu; }
#define XB_SPIN(cond, bar) do { unsigned _sp = 0; while (cond) { __builtin_amdgcn_s_sleep(1); \
    if ((++_sp & 255u) == 0u) { if (xb_ld(&(bar)[XB_TMO])) break; if (_sp > XB_SPIN_CAP) { atomicAdd(&(bar)[XB_TMO], 1u); break; } } } } while (0)

struct XcdBarrier {
    unsigned* bar; unsigned x;
    volatile LAS unsigned* st;
};

__device__ __forceinline__ XcdBarrier xcd_barrier_post(unsigned* bar, volatile LAS unsigned* st) {
    XcdBarrier b; b.bar = bar; b.x = xb_xcc_id(); b.st = st;
    if (threadIdx.x == 0) (void)xb_add(&bar[XB_XCNT(b.x)], 1u);
    return b;
}
__device__ __forceinline__ void xcd_barrier_complete(unsigned* bar, unsigned x, unsigned& nloc, unsigned& nx) {
    const unsigned G = gridDim.x * gridDim.y * gridDim.z;
    unsigned sum, cnt, mine, sp = 0u;
    for (;;) {
        sum = 0u; cnt = 0u; mine = 0u;
#pragma unroll
        for (unsigned j = 0; j < 16; ++j) { const unsigned c = xb_ld(&bar[XB_XCNT(j)]); sum += c; cnt += (c > 0u) ? 1u : 0u; mine = (j == x) ? c : mine; }
        if (sum == G) break;
        __builtin_amdgcn_s_sleep(1);
        if ((++sp & 255u) == 0u) { if (xb_ld(&bar[XB_TMO])) break; if (sp > XB_SPIN_CAP) { atomicAdd(&bar[XB_TMO], 1u); break; } }
    }
    nloc = mine > 0u ? mine : 1u; nx = cnt > 0u ? cnt : 1u;
}

__device__ __forceinline__ void xcd_barrier(const XcdBarrier& b) {
    asm volatile("s_waitcnt vmcnt(0)" ::: "memory");
    __syncthreads();
    if (threadIdx.x == 0) {
        unsigned* bar = b.bar;
        __builtin_amdgcn_s_waitcnt(0);
        unsigned nloc = b.st[0], nx = b.st[1];
        if (nloc == 0u) { xcd_barrier_complete(bar, b.x, nloc, nx); b.st[0] = nloc; b.st[1] = nx; }
        const unsigned old = xb_add(&bar[XB_XSUB(b.x)], 1u);
        const unsigned gen = old / nloc;
        if (old + 1u == (gen + 1u) * nloc) {
            __builtin_amdgcn_fence(__ATOMIC_RELEASE, "agent");
            asm volatile("s_waitcnt vmcnt(0)" ::: "memory");
            const unsigned og = xb_add(&bar[XB_TOP], 1u);
            const unsigned tg = og / nx;
            if (og + 1u == (tg + 1u) * nx) xb_add(&bar[XB_TOPGEN], 1u);
            else XB_SPIN(xb_ld(&bar[XB_TOPGEN]) == tg, bar);
            __builtin_amdgcn_fence(__ATOMIC_ACQUIRE, "agent");
            xb_add(&bar[XB_XGEN(b.x)], 1u);
            asm volatile("s_waitcnt vmcnt(0)" ::: "memory");
        } else {
            XB_SPIN(xb_ld(&bar[XB_XGEN(b.x)]) == gen, bar);
            __builtin_amdgcn_fence(__ATOMIC_ACQUIRE, "agent");
            asm volatile("s_waitcnt vmcnt(0)" ::: "memory");
        }
    }
    __syncthreads();
}


#ifndef GMT
#define GMT 3
#endif
#ifndef COOP
#define COOP 1
#endif

constexpr int NTOK = 12288, NPR = 4096;
constexpr size_t MiB = (size_t)1 << 20, KiB = 1024;
constexpr size_t OFF_W1T = 0, OFF_W2T = 11 * MiB, OFF_WIN = 16 * MiB + 512 * KiB, OFF_CIN = 0;
constexpr size_t OFF_WML = 34 * MiB + 512 * KiB, OFF_WSC = OFF_WML + 2 * MiB, OFF_WO = OFF_WSC + 2 * MiB;
constexpr size_t OFF_MOD = 40 * MiB + 512 * KiB, OFF_BINP = OFF_MOD + 112 * KiB, OFF_GATES = OFF_BINP + 40 * KiB;
constexpr size_t OFF_BQ = OFF_GATES + 768 * KiB, OFF_GI = OFF_BQ + 384 * KiB, OFF_PMX = OFF_GI + 384 * KiB;
constexpr size_t OFF_BL = OFF_PMX + 384 * KiB, OFF_MLOC = OFF_BL + 4 * KiB, OFF_DN = OFF_MLOC + 4 * KiB;
constexpr size_t OFF_BAR = OFF_DN + 384 * KiB;
constexpr size_t OFF_Z = 44 * MiB, TB = 24 * MiB;
constexpr size_t OFF_F2 = 236 * MiB;
constexpr int ST_OFF = 161792;
constexpr int LDS_BYTES = 162048;

struct Params {
    const float *x_prompt, *x_sample, *state_C, *state_n, *state_m, *c, *c_ctx, *w_mod, *b_mod, *norm_g, *ffn1_w1, *ffn1_w2, *w_in, *b_in,
        *conv_w, *conv_b, *ml_norm, *w_ml_out, *w_sc_out, *w_o, *ffn2_w1, *ffn2_w2, *final_norm;
    float* out; unsigned char* ws; int phase_lo, phase_hi, rep_mask, pad_;
};

DEVI float bf2f(unsigned short b) { return __uint_as_float(((unsigned)b) << 16); }
DEVI float bf_lo(unsigned u) { return __uint_as_float(u << 16); }
DEVI float bf_hi(unsigned u) { return __uint_as_float(u & 0xffff0000u); }
DEVI unsigned short f2bf(float f) { return (unsigned short)(cvt_pk_bf16(f, f) & 0xffffu); }
DEVI float sigm(float x) { return 1.f / (1.f + __expf(-x)); }
DEVI float silu(float x) { return x / (1.f + __expf(-x)); }
DEVI int cond_of_row(int row) { return row < NPR ? 0 : 1 + ((row - NPR) >> 12); }
DEVI bf16_t* zbuf(const Params& p, int i) { return (bf16_t*)(p.ws + OFF_Z + (size_t)i * TB); }
DEVI float wave_sum(float v) { v += __shfl_xor(v, 32); v += __shfl_xor(v, 16); v += __shfl_xor(v, 8); v += __shfl_xor(v, 4); v += __shfl_xor(v, 2); v += __shfl_xor(v, 1); return v; }

DEVI int win_src_col(int L) {
    if (L < 4096) return L;
    if (L < 5120) return 4112 + (L - 4096);
    if (L < 7168) { const int o = L - 5120, j = o >> 8, w = o & 255; return (w < 128) ? (5136 + 128 * j + w) : (6160 + 128 * j + (w - 128)); }
    if (L < 8192) return 7184 + (L - 7168);
    return 8208 + (L - 8192);
}
DEVI int w1_src_col(int L) { const int j = L >> 8, w = L & 255; return (w < 128) ? (128 * j + w) : (2816 + 128 * j + (w - 128)); }

DEVI void conv_tile(const float* __restrict__ src, int ldsrc, int col0, bf16_t* __restrict__ dst, int Ktot, int L0, int k0, unsigned char* shm) {
    unsigned short* T = (unsigned short*)shm;
    const int t = threadIdx.x, nq = t & 15, kr = t >> 4;
#pragma unroll
    for (int ps = 0; ps < 8; ++ps) { const int k = ps * 32 + kr; const f32x4 v4_ = __builtin_nontemporal_load((const f32x4*)(src + (size_t)(k0 + k) * ldsrc + col0 + 4 * nq)); float4 v; v.x = v4_[0]; v.y = v4_[1]; v.z = v4_[2]; v.w = v4_[3];
        T[(4 * nq + 0) * 258 + k] = f2bf(v.x); T[(4 * nq + 1) * 258 + k] = f2bf(v.y); T[(4 * nq + 2) * 258 + k] = f2bf(v.z); T[(4 * nq + 3) * 258 + k] = f2bf(v.w); }
    __syncthreads();
#pragma unroll
    for (int ps = 0; ps < 4; ++ps) { const int n = ps * 16 + (t >> 5), k8 = (t & 31) * 8; const unsigned* s = (const unsigned*)(T + n * 258 + k8);
        u32x4 w; w.x = s[0]; w.y = s[1]; w.z = s[2]; w.w = s[3]; *(u32x4*)(dst + (size_t)(L0 + n) * Ktot + k0 + k8) = w; }
    __syncthreads();
}
DEVI void conv_ffn(const float* w1, const float* w2, size_t off, const Params& p, int it, unsigned char* shm) {
    if (it < 352) { const int nb = it >> 2, kb = it & 3; conv_tile(w1, 5632, w1_src_col(64 * nb), (bf16_t*)(p.ws + off), 1024, 64 * nb, 256 * kb, shm); }
    else { const int i2 = it - 352, nb = i2 / 11, kb = i2 % 11; conv_tile(w2, 1024, 64 * nb, (bf16_t*)(p.ws + off + 11 * MiB), 2816, 64 * nb, 256 * kb, shm); }
}
struct ConvDesc { const float* src; bf16_t* dst; int ldsrc, col0, Ktot, L0, k0; };
DEVI ConvDesc conv_desc(const Params& p, int list, int it) {
    ConvDesc d;
    if (it < 352) { const int nb = it >> 2, kb = it & 3; d.src = list ? p.ffn2_w1 : p.ffn1_w1; d.ldsrc = 5632; d.col0 = w1_src_col(64 * nb); d.dst = (bf16_t*)(p.ws + (list ? OFF_F2 : OFF_W1T)); d.Ktot = 1024; d.L0 = 64 * nb; d.k0 = 256 * kb; }
    else if (it < 528) { const int i2 = it - 352, nb = i2 / 11, kb = i2 % 11; d.src = list ? p.ffn2_w2 : p.ffn1_w2; d.ldsrc = 1024; d.col0 = 64 * nb; d.dst = (bf16_t*)(p.ws + (list ? OFF_F2 : OFF_W1T) + 11 * MiB); d.Ktot = 2816; d.L0 = 64 * nb; d.k0 = 256 * kb; }
    else if (it < 1104) { const int i2 = it - 528, nb = i2 >> 2, kb = i2 & 3; d.src = p.w_in; d.ldsrc = 9232; d.col0 = win_src_col(64 * nb); d.dst = (bf16_t*)(p.ws + OFF_WIN); d.Ktot = 1024; d.L0 = 64 * nb; d.k0 = 256 * kb; }
    else { const int i2 = it - 1104, mtx = i2 >> 6, i3 = i2 & 63, nb = i3 >> 2, kb = i3 & 3;
        d.src = mtx == 0 ? p.w_ml_out : (mtx == 1 ? p.w_sc_out : p.w_o); d.dst = (bf16_t*)(p.ws + (mtx == 0 ? OFF_WML : (mtx == 1 ? OFF_WSC : OFF_WO)));
        d.ldsrc = 1024; d.col0 = 64 * nb; d.Ktot = 1024; d.L0 = 64 * nb; d.k0 = 256 * kb; }
    return d;
}
DEVI void conv_load(f32x4 (&r)[8], const ConvDesc& d) {
    const int t = threadIdx.x, nq = t & 15, kp = t >> 4;
#pragma unroll
    for (int ps = 0; ps < 4; ++ps) { const float* s = d.src + (size_t)(d.k0 + ps * 64 + 2 * kp) * d.ldsrc + d.col0 + 4 * nq;
        r[2 * ps] = __builtin_nontemporal_load((const f32x4*)s); r[2 * ps + 1] = __builtin_nontemporal_load((const f32x4*)(s + d.ldsrc)); }
}
DEVI void conv_items(const Params& p, unsigned char* shm, int list, int first, int end, int stride) {
    if (first >= end) return;
    unsigned* T = (unsigned*)shm;
    const int t = threadIdx.x, nq = t & 15, kp = t >> 4;
    f32x4 r[8];
    ConvDesc d = conv_desc(p, list, first); conv_load(r, d);
#pragma unroll 1
    for (int it = first; it < end; it += stride) {
#pragma unroll
        for (int ps = 0; ps < 4; ++ps)
#pragma unroll
            for (int j = 0; j < 4; ++j) T[(4 * nq + j) * 129 + ps * 32 + kp] = cvt_pk_bf16(r[2 * ps][j], r[2 * ps + 1][j]);
        __syncthreads();
        ConvDesc dn = d; const bool hn = it + stride < end;
        if (hn) { dn = conv_desc(p, list, it + stride); conv_load(r, dn); }
#pragma unroll
        for (int ps = 0; ps < 4; ++ps) { const int n = ps * 16 + (t >> 5), k8 = (t & 31) * 8; const unsigned* s = T + n * 129 + (k8 >> 1);
            u32x4 w; w.x = s[0]; w.y = s[1]; w.z = s[2]; w.w = s[3]; *(u32x4*)(d.dst + (size_t)(d.L0 + n) * d.Ktot + d.k0 + k8) = w; }
        __syncthreads();
        d = dn;
    }
}
DEVI void phase0(const Params& p, unsigned char* shm) {
    const int t = threadIdx.x;
    float* mod = (float*)(p.ws + OFF_MOD);
    {
        float* sc = (float*)shm; float* red = sc + 3072;
        for (int i = t; i < 3072; i += 512) { const int b = i >> 10, k = i & 1023; const float v = (b == 0) ? p.c_ctx[k] : p.c[(b - 1) * 1024 + k]; sc[i] = silu(v); }
        __syncthreads();
        for (int it = blockIdx.x; it < 144; it += gridDim.x) {
            const int n0 = it * 64, nq = t & 15, kg = t >> 4;
            f32x4 a0 = {0.f, 0.f, 0.f, 0.f}, a1 = a0, a2 = a0;
#pragma unroll 8
            for (int kk = 0; kk < 32; ++kk) { const int k = kg * 32 + kk; const f32x4 w = __builtin_nontemporal_load((const f32x4*)(p.w_mod + (size_t)k * 9216 + n0 + 4 * nq));
                a0 += sc[k] * w; a1 += sc[1024 + k] * w; a2 += sc[2048 + k] * w; }
            *(f32x4*)(red + (kg * 3 + 0) * 64 + 4 * nq) = a0; *(f32x4*)(red + (kg * 3 + 1) * 64 + 4 * nq) = a1; *(f32x4*)(red + (kg * 3 + 2) * 64 + 4 * nq) = a2;
            __syncthreads();
            if (t < 192) { const int b = t >> 6, n = t & 63; float s = 0.f;
#pragma unroll
                for (int g = 0; g < 32; ++g) s += red[(g * 3 + b) * 64 + n];
                mod[b * 9216 + n0 + n] = s + p.b_mod[n0 + n]; }
            __syncthreads();
        }
    }
    {
        float* binp = (float*)(p.ws + OFF_BINP);
        for (int i = blockIdx.x * 512 + t; i < 9216; i += gridDim.x * 512) binp[i] = p.b_in[win_src_col(i)];
    }
    if (gridDim.x == 256) {
        const int b = blockIdx.x;
        if (b >= 144) conv_items(p, shm, 0, b - 144, 224, 112); else if (b < 128) conv_items(p, shm, 0, 224 + b, 352, 128);
    } else conv_items(p, shm, 0, (int)blockIdx.x, 352, (int)gridDim.x);
}
DEVI void conv_rest(const Params& p, unsigned char* shm, int first, int stride) {
    for (int it = 352 + first; it < 1296; it += stride) {
        if (it < 528) conv_ffn(p.ffn1_w1, p.ffn1_w2, OFF_W1T, p, it, shm);
        else if (it < 1104) { const int i2 = it - 528, nb = i2 >> 2, kb = i2 & 3; conv_tile(p.w_in, 9232, win_src_col(64 * nb), (bf16_t*)(p.ws + OFF_WIN), 1024, 64 * nb, 256 * kb, shm); }
        else { const int i2 = it - 1104, mtx = i2 >> 6, i3 = i2 & 63, nb = i3 >> 2, kb = i3 & 3;
            const float* src = mtx == 0 ? p.w_ml_out : (mtx == 1 ? p.w_sc_out : p.w_o);
            bf16_t* dst = (bf16_t*)(p.ws + (mtx == 0 ? OFF_WML : (mtx == 1 ? OFF_WSC : OFF_WO)));
            conv_tile(src, 1024, 64 * nb, dst, 1024, 64 * nb, 256 * kb, shm); }
    }
}

template <int MODE> DEVI void row_phase(const Params& p, unsigned char* shm) {
    const int t = threadIdx.x, wid = t >> 6, lane = t & 63;
    const float* mod = (const float*)(p.ws + OFF_MOD);
    float* WgT = (float*)shm;
    if (MODE == 1) {
        for (int i = t; i < 16384; i += 512) { const int k = i >> 4, g = i & 15; WgT[g * 1024 + k] = p.w_in[(size_t)k * 9232 + 4096 + g]; }
        __syncthreads();
    }
    const float* gvec = MODE == 3 ? p.final_norm : p.norm_g + MODE * 1024;
    bf16_t* hout = MODE == 2 ? zbuf(p, 7) : (bf16_t*)(p.out + (size_t)NTOK * 1024);
    float* gates = (float*)(p.ws + OFF_GATES);
    f32x4 gv[4];
#pragma unroll
    for (int i = 0; i < 4; ++i) gv[i] = *(const f32x4*)(gvec + i * 256 + 4 * lane);
    if (MODE == 1) {
        const int stride = gridDim.x * 8;
        for (int rowA = blockIdx.x * 8 + wid; rowA < NTOK; rowA += 2 * stride) {
            const int rowB = rowA + stride; const bool hasB = rowB < NTOK; const int rB = hasB ? rowB : rowA;
            f32x4 va[4], vb[4]; float ssa = 0.f, ssb = 0.f;
#pragma unroll
            for (int i = 0; i < 4; ++i) { va[i] = *(const f32x4*)(p.out + (size_t)rowA * 1024 + i * 256 + 4 * lane); vb[i] = *(const f32x4*)(p.out + (size_t)rB * 1024 + i * 256 + 4 * lane); }
            f32x4 sa[4], ha[4], sb[4], hb[4];
            { const float* sh = mod + cond_of_row(rowA) * 9216 + 3 * 1024; const float* sh2 = mod + cond_of_row(rB) * 9216 + 3 * 1024;
#pragma unroll
              for (int i = 0; i < 4; ++i) { ha[i] = *(const f32x4*)(sh + i * 256 + 4 * lane); sa[i] = *(const f32x4*)(sh + 1024 + i * 256 + 4 * lane); hb[i] = *(const f32x4*)(sh2 + i * 256 + 4 * lane); sb[i] = *(const f32x4*)(sh2 + 1024 + i * 256 + 4 * lane); } }
#pragma unroll
            for (int i = 0; i < 4; ++i) { ssa += va[i][0] * va[i][0] + va[i][1] * va[i][1] + va[i][2] * va[i][2] + va[i][3] * va[i][3]; ssb += vb[i][0] * vb[i][0] + vb[i][1] * vb[i][1] + vb[i][2] * vb[i][2] + vb[i][3] * vb[i][3]; }
            ssa = wave_sum(ssa); ssb = wave_sum(ssb);
            const float ra = rsqrtf(ssa * (1.f / 1024.f) + 1e-6f), rb = rsqrtf(ssb * (1.f / 1024.f) + 1e-6f);
#pragma unroll
            for (int i = 0; i < 4; ++i) { va[i] = va[i] * ra * gv[i] * (1.f + sa[i]) + ha[i]; vb[i] = vb[i] * rb * gv[i] * (1.f + sb[i]) + hb[i];
                u32x2 w; w.x = cvt_pk_bf16(va[i][0], va[i][1]); w.y = cvt_pk_bf16(va[i][2], va[i][3]); *(u32x2*)(hout + (size_t)rowA * 1024 + i * 256 + 4 * lane) = w;
                if (hasB) { u32x2 w2; w2.x = cvt_pk_bf16(vb[i][0], vb[i][1]); w2.y = cvt_pk_bf16(vb[i][2], vb[i][3]); *(u32x2*)(hout + (size_t)rowB * 1024 + i * 256 + 4 * lane) = w2; } }
            float pa[16], pb[16];
#pragma unroll
            for (int g = 0; g < 16; ++g) { float a = 0.f, b = 0.f;
#pragma unroll
                for (int i = 0; i < 4; ++i) { const f32x4 w4 = *(const f32x4*)(WgT + g * 1024 + i * 256 + 4 * lane);
                    a += va[i][0] * w4[0] + va[i][1] * w4[1] + va[i][2] * w4[2] + va[i][3] * w4[3]; b += vb[i][0] * w4[0] + vb[i][1] * w4[1] + vb[i][2] * w4[2] + vb[i][3] * w4[3]; }
                pa[g] = a; pb[g] = b; }
#define TRED(x, res) do { float b8[8], c4[4], d2[2]; bool up = (lane & 32) != 0; \
                _Pragma("unroll") for (int g = 0; g < 8; ++g) { const float snd = up ? x[g] : x[g + 8], kp = up ? x[g + 8] : x[g]; b8[g] = kp + __shfl_xor(snd, 32); } \
                up = (lane & 16) != 0; _Pragma("unroll") for (int g = 0; g < 4; ++g) { const float snd = up ? b8[g] : b8[g + 4], kp = up ? b8[g + 4] : b8[g]; c4[g] = kp + __shfl_xor(snd, 16); } \
                up = (lane & 8) != 0; _Pragma("unroll") for (int g = 0; g < 2; ++g) { const float snd = up ? c4[g] : c4[g + 2], kp = up ? c4[g + 2] : c4[g]; d2[g] = kp + __shfl_xor(snd, 8); } \
                up = (lane & 4) != 0; { const float snd = up ? d2[0] : d2[1], kp = up ? d2[1] : d2[0]; res = kp + __shfl_xor(snd, 4); } \
                res += __shfl_xor(res, 2); res += __shfl_xor(res, 1); } while (0)
            float ea, eb; TRED(pa, ea); TRED(pb, eb);
#undef TRED
            const int gidx = ((lane >> 5) & 1) * 8 + ((lane >> 4) & 1) * 4 + ((lane >> 3) & 1) * 2 + ((lane >> 2) & 1);
            if ((lane & 3) == 0) { const float bi = p.b_in[4096 + gidx]; gates[(size_t)rowA * 16 + gidx] = ea + bi; if (hasB) gates[(size_t)rowB * 16 + gidx] = eb + bi; }
        }
    } else
    for (int row = blockIdx.x * 8 + wid; row < NTOK; row += gridDim.x * 8) {
        const float* src = (MODE == 0) ? (row < NPR ? p.x_prompt + (size_t)row * 1024 : p.x_sample + (size_t)(row - NPR) * 1024) : p.out + (size_t)row * 1024;
        f32x4 v[4]; float ss = 0.f;
#pragma unroll
        for (int i = 0; i < 4; ++i) { v[i] = *(const f32x4*)(src + i * 256 + 4 * lane); ss += v[i][0] * v[i][0] + v[i][1] * v[i][1] + v[i][2] * v[i][2] + v[i][3] * v[i][3]; }
        ss = wave_sum(ss);
        const float rstd = rsqrtf(ss * (1.f / 1024.f) + 1e-6f);
        if (MODE == 3) {
#pragma unroll
            for (int i = 0; i < 4; ++i) *(f32x4*)(p.out + (size_t)row * 1024 + i * 256 + 4 * lane) = v[i] * rstd * gv[i];
        } else {
            const int b = cond_of_row(row);
            const float* sh = mod + b * 9216 + (MODE * 3) * 1024; const float* scl = sh + 1024;
            f32x4 s4v[4], h4v[4];
#pragma unroll
            for (int i = 0; i < 4; ++i) { s4v[i] = *(const f32x4*)(scl + i * 256 + 4 * lane); h4v[i] = *(const f32x4*)(sh + i * 256 + 4 * lane); }
#pragma unroll
            for (int i = 0; i < 4; ++i) { const f32x4 s4 = s4v[i], h4 = h4v[i];
                v[i] = v[i] * rstd * gv[i] * (1.f + s4) + h4;
                u32x2 w; w.x = cvt_pk_bf16(v[i][0], v[i][1]); w.y = cvt_pk_bf16(v[i][2], v[i][3]);
                *(u32x2*)(hout + (size_t)row * 1024 + i * 256 + 4 * lane) = w; }
            if (MODE == 1) {
                float my = 0.f;
#pragma unroll
                for (int g = 0; g < 16; ++g) { float a = 0.f;
#pragma unroll
                    for (int i = 0; i < 4; ++i) { const f32x4 w4 = *(const f32x4*)(WgT + g * 1024 + i * 256 + 4 * lane); a += v[i][0] * w4[0] + v[i][1] * w4[1] + v[i][2] * w4[2] + v[i][3] * w4[3]; }
                    a = wave_sum(a); if (lane == g) my = a; }
                if (lane < 16) gates[(size_t)row * 16 + lane] = my + p.b_in[4096 + lane];
            }
        }
    }
    __syncthreads();
}

struct EpiSwiglu {
    static constexpr bool PERM = true, AFTER_DRAIN = false; bf16_t* O;
    template <int MT> DEVI void operator()(const f32x4 (&acc)[2][2][MT][2], const Unit& u, int wr, int wc, int fr, int fq) const {
        const int row0 = u.pm * 64 * MT + wr * 16 * MT + fr, col0 = u.pn * 128 + wc * 32 + 8 * fq;
#pragma unroll
        for (int ai = 0; ai < 2; ++ai)
#pragma unroll
            for (int m = 0; m < MT; ++m) { bf16_t* rowp = O + (size_t)(row0 + ai * 32 * MT + m * 16) * 2816 + col0;
                float r[8];
#pragma unroll
                for (int n = 0; n < 2; ++n)
#pragma unroll
                    for (int j = 0; j < 4; ++j) r[4 * n + j] = silu(acc[ai][0][m][n][j]) * acc[ai][1][m][n][j];
                u32x4 w; w.x = cvt_pk_bf16(r[0], r[1]); w.y = cvt_pk_bf16(r[2], r[3]); w.z = cvt_pk_bf16(r[4], r[5]); w.w = cvt_pk_bf16(r[6], r[7]);
                *(u32x4*)rowp = w; }
    }
};
struct EpiResid {
    static constexpr bool PERM = false, AFTER_DRAIN = false; const float* xa; const float* xb; float* xo; const float* gate; float scale;
    template <int MT> DEVI void operator()(const f32x4 (&acc)[2][2][MT][2], const Unit& u, int wr, int wc, int fr, int fq) const {
        const int row0 = u.pm * 64 * MT + wr * 16 * MT + fr, col0 = u.pn * 256 + wc * 32 + 4 * fq;
        const int c_lo = cond_of_row(u.pm * 64 * MT), c_hi = cond_of_row(u.pm * 64 * MT + 64 * MT - 1);
        f32x4 g0[2][2], g1[2][2];
#pragma unroll
        for (int bj = 0; bj < 2; ++bj)
#pragma unroll
            for (int n = 0; n < 2; ++n) { g0[bj][n] = scale * *(const f32x4*)(gate + c_lo * 9216 + col0 + bj * 128 + n * 16); g1[bj][n] = scale * *(const f32x4*)(gate + c_hi * 9216 + col0 + bj * 128 + n * 16); }
#pragma unroll
        for (int ai = 0; ai < 2; ++ai) {
            f32x4 xv[MT][2][2];
#pragma unroll
            for (int m = 0; m < MT; ++m) { const int row = row0 + ai * 32 * MT + m * 16;
                const float* xi = (row < NPR) ? xa + (size_t)row * 1024 : xb + (size_t)(row - NPR) * 1024;
#pragma unroll
                for (int bj = 0; bj < 2; ++bj)
#pragma unroll
                    for (int n = 0; n < 2; ++n) xv[m][bj][n] = *(const f32x4*)(xi + col0 + bj * 128 + n * 16); }
#pragma unroll
            for (int m = 0; m < MT; ++m) { const int row = row0 + ai * 32 * MT + m * 16; float* xop = xo + (size_t)row * 1024; const bool hi = cond_of_row(row) != c_lo;
#pragma unroll
                for (int bj = 0; bj < 2; ++bj)
#pragma unroll
                    for (int n = 0; n < 2; ++n) { const f32x4 gv = hi ? g1[bj][n] : g0[bj][n]; *(f32x4*)(xop + col0 + bj * 128 + n * 16) = xv[m][bj][n] + gv * acc[ai][bj][m][n]; } }
        }
    }
};
struct EpiZ {
    static constexpr bool PERM = true, AFTER_DRAIN = false; unsigned char* zbase; const float* binp;
    template <int MT> DEVI void operator()(const f32x4 (&acc)[2][2][MT][2], const Unit& u, int wr, int wc, int fr, int fq) const {
        const int pn = u.pn, row0 = u.pm * 64 * MT + wr * 16 * MT + fr, cl = wc * 32 + 8 * fq;
        f32x4 bv[2][2];
#pragma unroll
        for (int bj = 0; bj < 2; ++bj)
#pragma unroll
            for (int n = 0; n < 2; ++n) bv[bj][n] = *(const f32x4*)(binp + pn * 256 + bj * 128 + cl + 4 * n);
        if (pn >= 20 && pn < 28) {
            bf16_t* O = (bf16_t*)(zbase + 5 * TB) + (pn - 20) * 128 + cl;
#pragma unroll
            for (int ai = 0; ai < 2; ++ai)
#pragma unroll
                for (int m = 0; m < MT; ++m) { float r[8];
#pragma unroll
                    for (int n = 0; n < 2; ++n)
#pragma unroll
                        for (int j = 0; j < 4; ++j) r[4 * n + j] = (acc[ai][0][m][n][j] + bv[0][n][j]) * (acc[ai][1][m][n][j] + bv[1][n][j]);
                    u32x4 w; w.x = cvt_pk_bf16(r[0], r[1]); w.y = cvt_pk_bf16(r[2], r[3]); w.z = cvt_pk_bf16(r[4], r[5]); w.w = cvt_pk_bf16(r[6], r[7]);
                    *(u32x4*)(O + (size_t)(row0 + ai * 32 * MT + m * 16) * 1024) = w; }
        } else {
            const int seg = pn < 20 ? (pn >> 2) : (pn < 32 ? 6 : 7);
            const int cb = pn < 20 ? (pn & 3) * 256 : ((pn - 28) & 3) * 256;
            const bool sg = (seg == 3) || (seg >= 6); const float mul = (seg == 1) ? 0.0625f : 1.f;
            bf16_t* O = (bf16_t*)(zbase + (size_t)seg * TB) + cb + cl;
#pragma unroll
            for (int ai = 0; ai < 2; ++ai)
#pragma unroll
                for (int m = 0; m < MT; ++m)
#pragma unroll
                    for (int bj = 0; bj < 2; ++bj) { float r[8];
#pragma unroll
                        for (int n = 0; n < 2; ++n)
#pragma unroll
                            for (int j = 0; j < 4; ++j) { float x = (acc[ai][bj][m][n][j] + bv[bj][n][j]) * mul; r[4 * n + j] = sg ? sigm(x) : x; }
                        u32x4 w; w.x = cvt_pk_bf16(r[0], r[1]); w.y = cvt_pk_bf16(r[2], r[3]); w.z = cvt_pk_bf16(r[4], r[5]); w.w = cvt_pk_bf16(r[6], r[7]);
                        *(u32x4*)(O + (size_t)(row0 + ai * 32 * MT + m * 16) * 1024 + bj * 128) = w; }
        }
    }
};
template <int SECOND> struct EpiY {
    static constexpr bool PERM = true, AFTER_DRAIN = false; const bf16_t* gate; bf16_t* Y;
    template <int MT> DEVI void operator()(const f32x4 (&acc)[2][2][MT][2], const Unit& u, int wr, int wc, int fr, int fq) const {
        const int row0 = u.pm * 64 * MT + wr * 16 * MT + fr, col0 = u.pn * 256 + wc * 32 + 8 * fq;
#pragma unroll
        for (int ai = 0; ai < 2; ++ai)
        { u32x4 gws[MT][2], yws[MT][2];
#pragma unroll
            for (int m = 0; m < MT; ++m)
#pragma unroll
                for (int bj = 0; bj < 2; ++bj) { const size_t off = (size_t)(row0 + ai * 32 * MT + m * 16) * 1024 + col0 + bj * 128; gws[m][bj] = *(const u32x4*)(gate + off); if (SECOND) yws[m][bj] = *(const u32x4*)(Y + off); }
#pragma unroll
            for (int m = 0; m < MT; ++m)
#pragma unroll
                for (int bj = 0; bj < 2; ++bj) { const size_t off = (size_t)(row0 + ai * 32 * MT + m * 16) * 1024 + col0 + bj * 128;
                    const u32x4 gw = gws[m][bj]; float r[8];
                    r[0] = bf_lo(gw.x) * acc[ai][bj][m][0][0]; r[1] = bf_hi(gw.x) * acc[ai][bj][m][0][1]; r[2] = bf_lo(gw.y) * acc[ai][bj][m][0][2]; r[3] = bf_hi(gw.y) * acc[ai][bj][m][0][3];
                    r[4] = bf_lo(gw.z) * acc[ai][bj][m][1][0]; r[5] = bf_hi(gw.z) * acc[ai][bj][m][1][1]; r[6] = bf_lo(gw.w) * acc[ai][bj][m][1][2]; r[7] = bf_hi(gw.w) * acc[ai][bj][m][1][3];
                    if (SECOND) { const u32x4 yw = yws[m][bj];
                        r[0] += bf_lo(yw.x); r[1] += bf_hi(yw.x); r[2] += bf_lo(yw.y); r[3] += bf_hi(yw.y); r[4] += bf_lo(yw.z); r[5] += bf_hi(yw.z); r[6] += bf_lo(yw.w); r[7] += bf_hi(yw.w); }
                    u32x4 w; w.x = cvt_pk_bf16(r[0], r[1]); w.y = cvt_pk_bf16(r[2], r[3]); w.z = cvt_pk_bf16(r[4], r[5]); w.w = cvt_pk_bf16(r[6], r[7]);
                    *(u32x4*)(Y + off) = w; } }
    }
};
template <int MT, class Epi> DEVI void run_gemm(const bf16_t* A, const bf16_t* Bt, int N, int K, const Epi& E, unsigned char* shm) {
    pg8::Gemm g; g.A = A; g.Bt = Bt; g.M = NTOK; g.N = N; g.K = K;
    pg8::StaticOrder S; S.init(NTOK, N, (int)gridDim.x, (int)blockIdx.x, 64 * MT);
    pg8::gemm_phase<Epi, pg8::StaticOrder, false, MT>((PG8_LAS unsigned char*)shm, g, S, E, nullptr);
    __syncthreads();
}

namespace ml {
constexpr int S_OFF = 0, A_OFF = 67584, B_OFF = 86016, T_BYTES = 33792, V_OFF = 153600;
template <int NP> DEVI void ld_nat(int tid, u32x4 (&r)[NP], const bf16_t* src, int ld) {
#pragma unroll
    for (int i = 0; i < NP; ++i) { const int idx = tid + 512 * i, row = idx >> 3, cp = idx & 7; r[i] = *(const u32x4*)(src + (size_t)row * ld + cp * 8); }
}
template <int NP> DEVI void st_nat(int tid, const u32x4 (&r)[NP], unsigned char* dst) {
#pragma unroll
    for (int i = 0; i < NP; ++i) { const int idx = tid + 512 * i, row = idx >> 3, cp = idx & 7; *(u32x4*)(dst + row * 144 + cp * 16) = r[i]; }
}
template <int NP> DEVI void ld_tr(int tid, u32x4 (&r)[NP], const bf16_t* src, int ld) {
    constexpr int PPR = NP * 8;
#pragma unroll
    for (int i = 0; i < NP; ++i) { const int idx = tid + 512 * i, kr = idx / PPR, cp = idx % PPR; r[i] = *(const u32x4*)(src + (size_t)kr * ld + cp * 8); }
}
template <int NP> DEVI void st_tr(int tid, const u32x4 (&r)[NP], unsigned char* T) {
    constexpr int PPR = NP * 8;
#pragma unroll
    for (int i = 0; i < NP; ++i) { const int idx = tid + 512 * i, kr = idx / PPR, cp = idx % PPR; *(u32x4*)(T + kr * 528 + cp * 16) = r[i]; }
}
typedef short v4i16 __attribute__((ext_vector_type(4)));
DEVI bf16x8 tr_frag(const unsigned char* T, int k0, int n0, int lane) {
    const int i = lane & 15, g = lane >> 4;
    const LAS v4i16* p = (const LAS v4i16*)(T + (k0 + 8 * g + (i >> 2)) * 528 + (n0 + 4 * (i & 3)) * 2);
    const v4i16 lo = __builtin_amdgcn_ds_read_tr16_b64_v4i16((LAS v4i16*)p), hi = __builtin_amdgcn_ds_read_tr16_b64_v4i16((LAS v4i16*)(p + 264));
    bf16x8 r; r[0] = lo[0]; r[1] = lo[1]; r[2] = lo[2]; r[3] = lo[3]; r[4] = hi[0]; r[5] = hi[1]; r[6] = hi[2]; r[7] = hi[3]; return r;
}
template <bool AT, bool BT> DEVI void mma_slab(f32x4 (&acc)[4][4], const unsigned char* Ab, int astride, const unsigned char* Bb, int wr, int wc, int lane) {
    const int fr = lane & 15, fq = lane >> 4;
#pragma unroll
    for (int ks = 0; ks < 2; ++ks) { bf16x8 a[4], b[4];
#pragma unroll
        for (int m = 0; m < 4; ++m) a[m] = AT ? tr_frag(Ab, 32 * ks, 64 * wr + 16 * m, lane) : *(const bf16x8*)(Ab + (64 * wr + 16 * m + fr) * astride + (32 * ks + 8 * fq) * 2);
#pragma unroll
        for (int n = 0; n < 4; ++n) b[n] = BT ? tr_frag(Bb, 32 * ks, 64 * wc + 16 * n, lane) : *(const bf16x8*)(Bb + (64 * wc + 16 * n + fr) * 144 + (32 * ks + 8 * fq) * 2);
#pragma unroll
        for (int m = 0; m < 4; ++m)
#pragma unroll
            for (int n = 0; n < 4; ++n) acc[m][n] = __builtin_amdgcn_mfma_f32_16x16x32_bf16(b[n], a[m], acc[m][n], 0, 0, 0); }
}
template <int AM, int BM, int DP> DEVI void bgemm(f32x4 (&acc)[4][4], unsigned char* shm, const bf16_t* Asrc, int lda, const bf16_t* Bsrc, int ldb, int nslab, int a_koff, const float* ascale) {
    u32x4 ra[DP][2], rb[DP][4];
    int t = threadIdx.x; asm volatile("" : "+v"(t));
    const int wid = t >> 6, lane = t & 63, wr = wid >> 2, wc = wid & 3;
    constexpr bool AG = (AM == 0 || AM == 3);
#define BG_LOAD(d, i) do { if (AG) ld_nat<2>(t, ra[d], Asrc + (i) * 64, lda); \
        if (BM == 0) ld_nat<4>(t, rb[d], Bsrc + (i) * 64, ldb); else ld_tr<4>(t, rb[d], Bsrc + (size_t)(i) * 64 * ldb, ldb); } while (0)
#pragma unroll
    for (int d = 0; d < DP; ++d) if (d < nslab) BG_LOAD(d, d);
#pragma unroll 1
    for (int i0 = 0; i0 < nslab; i0 += DP) {
#pragma unroll
        for (int d = 0; d < DP; ++d) { const int i = i0 + d;
            if (i < nslab) {
                unsigned char* Bb = shm + B_OFF + ((BM == 1) ? (i & 1) * T_BYTES : 0);
                if (AM == 0) st_nat<2>(t, ra[d], shm + A_OFF);
                if (AM == 3) {
#pragma unroll
                    for (int q = 0; q < 2; ++q) { const int idx = t + 512 * q, row = idx >> 3, cp = idx & 7; const float w = ascale[row]; const u32x4 x = ra[d][q]; u32x4 y;
                        y.x = cvt_pk_bf16(bf_lo(x.x) * w, bf_hi(x.x) * w); y.y = cvt_pk_bf16(bf_lo(x.y) * w, bf_hi(x.y) * w); y.z = cvt_pk_bf16(bf_lo(x.z) * w, bf_hi(x.z) * w); y.w = cvt_pk_bf16(bf_lo(x.w) * w, bf_hi(x.w) * w);
                        *(u32x4*)(shm + A_OFF + row * 144 + cp * 16) = y; } }
                if (BM == 0) st_nat<4>(t, rb[d], Bb); else st_tr<4>(t, rb[d], Bb);
                LBAR();
                if (i + DP < nslab) BG_LOAD(d, i + DP);
                mma_slab<false, BM == 1>(acc, (AM == 2) ? (shm + S_OFF + (a_koff + i * 64) * 2) : (shm + A_OFF), (AM == 2) ? 528 : 144, Bb, wr, wc, lane);
                if (AG || BM == 0) LBAR();
            } }
    }
#undef BG_LOAD
    if (AM == 2 && BM == 1) __syncthreads();
}
DEVI void zero_acc(f32x4 (&a)[4][4]) {
#pragma unroll
    for (int m = 0; m < 4; ++m)
#pragma unroll
        for (int n = 0; n < 4; ++n) a[m][n] = (f32x4){0.f, 0.f, 0.f, 0.f};
}
constexpr int TBL_OFF = 159744;
DEVI void chain_table(const Params& p, unsigned char* shm) {
    float* tbl = (float*)(shm + TBL_OFF); const int t = threadIdx.x;
    if (t < 16) { const int b = t >> 3, dh = t & 7, dir = dh >> 2, base = dh * 48 + 16 + b * 16;
        const float* bl = (const float*)(p.ws + OFF_BL) + base; const float* ml = (const float*)(p.ws + OFF_MLOC) + base;
        float blv[16], mlv[16];
#pragma unroll
        for (int s = 0; s < 16; ++s) { const int c = dir ? 15 - s : s; blv[s] = bl[c]; mlv[s] = ml[c]; }
        float m = p.state_m[b * 8 + dh];
#pragma unroll
        for (int s = 0; s < 16; ++s) { const int c = dir ? 15 - s : s; tbl[t * 16 + c] = m; m = fmaxf(blv[s] + m, mlv[s]); } }
    __syncthreads();
}
DEVI void chain_m(const Params& p, const unsigned char* shm, int cgk, int dh, float& m_in, float& m_out) {
    const float* tbl = (const float*)(shm + TBL_OFF);
    float m = 0.f;
    if (cgk >= 16) { const int lc = cgk - 16; m = tbl[((lc >> 4) * 8 + dh) * 16 + (lc & 15)]; }
    m_in = m; m_out = fmaxf(((const float*)(p.ws + OFF_BL))[dh * 48 + cgk] + m, ((const float*)(p.ws + OFF_MLOC))[dh * 48 + cgk]);
}
DEVI void m1_pair(const Params& p, int pair, unsigned char* shm) {
    float* sm = (float*)shm; const int t = threadIdx.x, lane = t & 63, wid = t >> 6, pos = t & 255, item = pair * 2 + (t >> 8);
    const int cgk = item >> 3, dh = item & 7, dir = dh >> 2, w4 = wid & 3, wb = wid & 4;
    const float* gates = (const float*)(p.ws + OFF_GATES);
    const int tok = cgk * 256 + (dir ? 255 - pos : pos);
    const float ii = gates[(size_t)tok * 16 + dh], f = gates[(size_t)tok * 16 + 8 + dh];
    float v = fminf(f, 0.f) - log1pf(expf(-fabsf(f)));
#pragma unroll
    for (int off = 1; off < 64; off <<= 1) { const float o = __shfl_up(v, off); if (lane >= off) v += o; }
    if (lane == 63) sm[wid] = v;
    __syncthreads();
    for (int k = 0; k < w4; ++k) v += sm[wb + k];
    const float b = v, gi = ii - b; float mx = gi;
#pragma unroll
    for (int off = 1; off < 64; off <<= 1) { const float o = __shfl_up(mx, off); if (lane >= off) mx = fmaxf(mx, o); }
    if (lane == 63) sm[8 + wid] = mx;
    __syncthreads();
    for (int k = 0; k < w4; ++k) mx = fmaxf(mx, sm[8 + wb + k]);
    ((float*)(p.ws + OFF_BQ))[dh * NTOK + tok] = b; ((float*)(p.ws + OFF_GI))[dh * NTOK + tok] = gi; ((float*)(p.ws + OFF_PMX))[dh * NTOK + tok] = mx;
    if (pos == 255) { ((float*)(p.ws + OFF_BL))[dh * 48 + cgk] = b; ((float*)(p.ws + OFF_MLOC))[dh * 48 + cgk] = b + mx; }
    __syncthreads();
}
DEVI void m2_item(const Params& p, int item, unsigned char* shm) {
    int t = threadIdx.x; asm volatile("" : "+v"(t));
    const int wid = t >> 6, lane = t & 63, wr = wid >> 2, wc = wid & 3, fr = lane & 15, fq = lane >> 4;
    const int cgk = item >> 4, dh = (item >> 1) & 7, half = item & 1, head = dh & 3, r0 = cgk * 256;
    float m_in, m_out; chain_m(p, shm, cgk, dh, m_in, m_out);
    float* vwk = (float*)(shm + V_OFF);
    const float blv = ((const float*)(p.ws + OFF_BL))[dh * 48 + cgk];
    if (t < 256) vwk[t] = __expf(blv + ((const float*)(p.ws + OFF_GI))[dh * NTOK + r0 + t] - m_out);
    __syncthreads();
    const bf16_t* kb = zbuf(p, 1) + (size_t)r0 * 1024 + head * 256 + 128 * half; const bf16_t* vb = zbuf(p, 2) + (size_t)r0 * 1024 + head * 256;
    f32x4 acc[4][4]; zero_acc(acc);
    float dn = 0.f;
    u32x4 ra[2], rb[4];
    ld_tr<2>(t, ra, kb, 1024); ld_tr<4>(t, rb, vb, 1024);
#pragma unroll 1
    for (int i = 0; i < 4; ++i) {
        unsigned char* Ta = shm + S_OFF + (i & 1) * T_BYTES; unsigned char* Tb = shm + B_OFF + (i & 1) * T_BYTES;
#pragma unroll
        for (int q = 0; q < 2; ++q) { const int idx = t + 512 * q, kr = idx >> 4, cp = idx & 15; const float w = vwk[i * 64 + kr]; u32x4 x = ra[q], y;
            y.x = cvt_pk_bf16(bf_lo(x.x) * w, bf_hi(x.x) * w); y.y = cvt_pk_bf16(bf_lo(x.y) * w, bf_hi(x.y) * w); y.z = cvt_pk_bf16(bf_lo(x.z) * w, bf_hi(x.z) * w); y.w = cvt_pk_bf16(bf_lo(x.w) * w, bf_hi(x.w) * w);
            *(u32x4*)(Ta + kr * 528 + cp * 16) = y; }
        st_tr<4>(t, rb, Tb);
        LBAR();
        if (i + 1 < 4) { ld_tr<2>(t, ra, kb + (size_t)(i + 1) * 64 * 1024, 1024); ld_tr<4>(t, rb, vb + (size_t)(i + 1) * 64 * 1024, 1024); }
        {
            unsigned short dv_[16];
#pragma unroll
            for (int j = 0; j < 16; ++j) dv_[j] = *(const unsigned short*)(Ta + ((t >> 7) * 16 + j) * 528 + 2 * (t & 127));
#pragma unroll
            for (int j = 0; j < 16; ++j) dn += bf2f(dv_[j]); }
        mma_slab<true, true>(acc, Ta, 0, Tb, wr, wc, lane);
    }
    { float* dred = vwk + 256; dred[t] = dn; __syncthreads();
      if (t < 128) { dn = dred[t] + dred[t + 128] + dred[t + 256] + dred[t + 384];
        if (cgk < 16) p.out[(size_t)NTOK * 1024 + (size_t)16 * 8 * 65536 + (cgk * 8 + dh) * 256 + 128 * half + t] = dn;
        else ((float*)(p.ws + OFF_DN))[(dh * 48 + cgk) * 256 + 128 * half + t] = dn; } }
    if (cgk < 16) {
        float* C = p.out + (size_t)NTOK * 1024 + (size_t)(cgk * 8 + dh) * 65536;
#pragma unroll
        for (int m = 0; m < 4; ++m)
#pragma unroll
            for (int n = 0; n < 4; ++n) *(f32x4*)(C + (128 * half + 64 * wr + 16 * m + fr) * 256 + 64 * wc + 16 * n + 4 * fq) = acc[m][n];
        if (half == 0 && t == 0) p.out[(size_t)NTOK * 1024 + (size_t)16 * 8 * 65536 + 16 * 8 * 256 + cgk * 8 + dh] = m_out;
    } else {
        bf16_t* C = (bf16_t*)(p.ws + OFF_CIN) + (size_t)(dh * 32 + (cgk - 16)) * 65536;
#pragma unroll
        for (int m = 0; m < 4; ++m)
#pragma unroll
            for (int n = 0; n < 4; ++n) { u32x2 w; w.x = cvt_pk_bf16(acc[m][n][0], acc[m][n][1]); w.y = cvt_pk_bf16(acc[m][n][2], acc[m][n][3]);
                *(u32x2*)(C + (128 * half + 64 * wr + 16 * m + fr) * 256 + 64 * wc + 16 * n + 4 * fq) = w; }
    }
    __syncthreads();
}
DEVI void m3_phase(const Params& p) {
    const int t = threadIdx.x;
    for (int it = blockIdx.x; it < 256; it += gridDim.x) {
        const int chain = it >> 4, seg = it & 15, b = chain >> 3, dh = chain & 7, dir = dh >> 2;
        const size_t e0 = (size_t)seg * 4096 + t * 8;
        const float* bl = (const float*)(p.ws + OFF_BL) + dh * 48 + 16 + b * 16; const float* mlc = (const float*)(p.ws + OFF_MLOC) + dh * 48 + 16 + b * 16;
        bf16_t* base = (bf16_t*)(p.ws + OFF_CIN) + (size_t)(dh * 32 + b * 16) * 65536 + e0;
        float* nbase = (float*)(p.ws + OFF_DN) + (dh * 48 + 16 + b * 16) * 256 + t;
        const bool do_n = (seg == 0 && t < 256);
        u32x4 dv[16]; float dnv[16];
#pragma unroll
        for (int c = 0; c < 16; ++c) { dv[c] = *(const u32x4*)(base + (size_t)c * 65536); dnv[c] = do_n ? nbase[c * 256] : 0.f; }
        float st[8]; { const f32x4 a = *(const f32x4*)(p.state_C + (size_t)(b * 8 + dh) * 65536 + e0), c = *(const f32x4*)(p.state_C + (size_t)(b * 8 + dh) * 65536 + e0 + 4);
            st[0] = a[0]; st[1] = a[1]; st[2] = a[2]; st[3] = a[3]; st[4] = c[0]; st[5] = c[1]; st[6] = c[2]; st[7] = c[3]; }
        float sn = do_n ? p.state_n[(b * 8 + dh) * 256 + t] : 0.f;
        float m = p.state_m[b * 8 + dh];
#pragma unroll
        for (int step = 0; step < 16; ++step) {
            const int cf = step, cb = 15 - step;
            const float blv = dir ? bl[cb] : bl[cf], mlv = dir ? mlc[cb] : mlc[cf];
            const float m_new = fmaxf(blv + m, mlv), decay = __expf(blv + m - m_new);
            const u32x4 d4 = dir ? dv[cb] : dv[cf]; const float dn1 = dir ? dnv[cb] : dnv[cf];
            u32x4 w; w.x = cvt_pk_bf16(st[0], st[1]); w.y = cvt_pk_bf16(st[2], st[3]); w.z = cvt_pk_bf16(st[4], st[5]); w.w = cvt_pk_bf16(st[6], st[7]);
            *(u32x4*)(base + (size_t)(dir ? cb : cf) * 65536) = w;
            st[0] = decay * st[0] + bf_lo(d4.x); st[1] = decay * st[1] + bf_hi(d4.x); st[2] = decay * st[2] + bf_lo(d4.y); st[3] = decay * st[3] + bf_hi(d4.y);
            st[4] = decay * st[4] + bf_lo(d4.z); st[5] = decay * st[5] + bf_hi(d4.z); st[6] = decay * st[6] + bf_lo(d4.w); st[7] = decay * st[7] + bf_hi(d4.w);
            if (do_n) { nbase[(dir ? cb : cf) * 256] = sn; sn = decay * sn + dn1; }
            m = m_new;
        }
    }
}
DEVI void conv_phase(const Params& p) {
    const bf16_t* u = zbuf(p, 5); bf16_t* bg = zbuf(p, 4);
    const int c8 = (threadIdx.x & 127) * 8, rsub = threadIdx.x >> 7;
    float w0[8], w1[8], w2[8], cb[8];
#pragma unroll
    for (int q = 0; q < 2; ++q) { const f32x4 a = *(const f32x4*)(p.conv_w + c8 + 4 * q), b = *(const f32x4*)(p.conv_w + 1024 + c8 + 4 * q), c = *(const f32x4*)(p.conv_w + 2048 + c8 + 4 * q), d = *(const f32x4*)(p.conv_b + c8 + 4 * q);
#pragma unroll
        for (int j = 0; j < 4; ++j) { w0[4 * q + j] = a[j]; w1[4 * q + j] = b[j]; w2[4 * q + j] = c[j]; cb[4 * q + j] = d[j]; } }
    for (int row = blockIdx.x * 4 + rsub; row < NTOK; row += gridDim.x * 4) {
        const int per = row < NPR ? 256 : 64, pos = row & (per - 1);
        const size_t o = (size_t)row * 1024 + c8;
        const u32x4 z4 = {0u, 0u, 0u, 0u};
        const u32x4 uc = *(const u32x4*)(u + o), um = pos > 0 ? *(const u32x4*)(u + o - 1024) : z4, up = pos < per - 1 ? *(const u32x4*)(u + o + 1024) : z4, bv = *(const u32x4*)(bg + o);
        float r[8];
#pragma unroll
        for (int q = 0; q < 4; ++q) {
            r[2 * q] = bf_lo(bv[q]) * (w0[2 * q] * bf_lo(um[q]) + w1[2 * q] * bf_lo(uc[q]) + w2[2 * q] * bf_lo(up[q]) + cb[2 * q]);
            r[2 * q + 1] = bf_hi(bv[q]) * (w0[2 * q + 1] * bf_hi(um[q]) + w1[2 * q + 1] * bf_hi(uc[q]) + w2[2 * q + 1] * bf_hi(up[q]) + cb[2 * q + 1]); }
        u32x4 w; w.x = cvt_pk_bf16(r[0], r[1]); w.y = cvt_pk_bf16(r[2], r[3]); w.z = cvt_pk_bf16(r[4], r[5]); w.w = cvt_pk_bf16(r[6], r[7]);
        *(u32x4*)(bg + o) = w;
    }
}
DEVI void out_item(const Params& p, int item, unsigned char* shm) {
    const int cgk = item >> 3, head = (item >> 1) & 3, half = item & 1, r0 = cgk * 256, t0 = r0 + 128 * half;
    const bool latent = cgk >= 16;
    const bf16_t* qb = zbuf(p, 0) + (size_t)t0 * 1024 + head * 256; bf16_t* omb = zbuf(p, 0) + (size_t)t0 * 1024 + head * 256;     const bf16_t* kb = zbuf(p, 1) + (size_t)r0 * 1024 + head * 256;
    const bf16_t* vb = zbuf(p, 2) + (size_t)r0 * 1024 + head * 256; const bf16_t* ob = zbuf(p, 3) + (size_t)t0 * 1024 + head * 256;
    float* vgi = (float*)(shm + V_OFF); float* vmx = vgi + 256; float* vwi = vmx + 128; float* vsc = vwi + 128; float* vmt = vsc + 128; float* vqn = vmt + 128; float* red = vqn + 128;
    f32x4 h[4][4]; zero_acc(h);
#pragma unroll 1
    for (int dir = 0; dir < 2; ++dir) {
        int t = threadIdx.x; asm volatile("" : "+v"(t));
        const int wid = t >> 6, lane = t & 63, wr = wid >> 2, wc = wid & 3, fr = lane & 15, fq = lane >> 4;
        const int dh = dir * 4 + head;
        float m_in, m_out; chain_m(p, shm, cgk, dh, m_in, m_out);
        if (t < 256) vgi[t] = ((const float*)(p.ws + OFF_GI))[dh * NTOK + r0 + t];
        if (t < 128) { const float pm = ((const float*)(p.ws + OFF_PMX))[dh * NTOK + t0 + t], mx = fmaxf(m_in, pm);
            vmx[t] = mx; vwi[t] = __expf(m_in - mx); vmt[t] = ((const float*)(p.ws + OFF_BQ))[dh * NTOK + t0 + t] + mx; }
        {
            const int row = t >> 2, part = t & 3; float qn = 0.f;
            if (latent) { const float* nin = (const float*)(p.ws + OFF_DN) + (dh * 48 + cgk) * 256 + 64 * part;
#pragma unroll
                for (int i = 0; i < 8; ++i) { const u32x4 w = *(const u32x4*)(qb + (size_t)row * 1024 + 64 * part + 8 * i); const f32x4 n0 = *(const f32x4*)(nin + 8 * i), n1 = *(const f32x4*)(nin + 8 * i + 4);
                    qn += bf_lo(w.x) * n0[0] + bf_hi(w.x) * n0[1] + bf_lo(w.y) * n0[2] + bf_hi(w.y) * n0[3] + bf_lo(w.z) * n1[0] + bf_hi(w.z) * n1[1] + bf_lo(w.w) * n1[2] + bf_hi(w.w) * n1[3]; } }
            qn += __shfl_xor(qn, 1); qn += __shfl_xor(qn, 2);
            if (part == 0) vqn[row] = qn;
        }
        __syncthreads();
        {
            f32x4 acc[4][4]; zero_acc(acc);
            bgemm<0, 0, 1>(acc, shm, qb, 1024, kb, 1024, 4, 0, nullptr);
#pragma unroll
            for (int m = 0; m < 4; ++m) { const int tl = 64 * wr + 16 * m + fr, tt = 128 * half + tl; const float mx = vmx[tl]; float rs = 0.f;
#pragma unroll
                for (int n = 0; n < 4; ++n) { const int s0 = 64 * wc + 16 * n + 4 * fq;
#pragma unroll
                    for (int j = 0; j < 4; ++j) { const int s = s0 + j; const bool valid = dir == 0 ? (s <= tt) : (s >= tt); const float w = valid ? acc[m][n][j] * __expf(vgi[s] - mx) : 0.f; acc[m][n][j] = w; rs += w; } }
                rs += __shfl_xor(rs, 16); rs += __shfl_xor(rs, 32);
                if (fq == 0) red[tl * 4 + wc] = rs; }
            __syncthreads();
#pragma unroll
            for (int m = 0; m < 4; ++m) { const int tl = 64 * wr + 16 * m + fr; const f32x4 rr = *(const f32x4*)(red + tl * 4); const float wi = vwi[tl];
                const float den = rr[0] + rr[1] + rr[2] + rr[3] + wi * vqn[tl], rd = 1.f / fmaxf(fabsf(den), __expf(-vmt[tl]));
                if (wc == 0 && fq == 0) vsc[tl] = wi * rd;
#pragma unroll
                for (int n = 0; n < 4; ++n) { const int s0 = 64 * wc + 16 * n + 4 * fq;
                    u32x2 w; w.x = cvt_pk_bf16(acc[m][n][0] * rd, acc[m][n][1] * rd); w.y = cvt_pk_bf16(acc[m][n][2] * rd, acc[m][n][3] * rd); *(u32x2*)(shm + S_OFF + tl * 528 + s0 * 2) = w; } }
        }
        __syncthreads();
        if (latent) bgemm<3, 1, 2>(h, shm, qb, 1024, (const bf16_t*)(p.ws + OFF_CIN) + (size_t)(dh * 32 + (cgk - 16)) * 65536, 256, 4, 0, vsc);
        const int s_lo = dir == 0 ? 0 : 2 * half, s_hi = dir == 0 ? 2 * (half + 1) : 4;
        bgemm<2, 1, 2>(h, shm, nullptr, 0, vb + (size_t)(64 * s_lo) * 1024, 1024, s_hi - s_lo, 64 * s_lo, nullptr);
    }
    int t = threadIdx.x; asm volatile("" : "+v"(t));
    const int wid = t >> 6, lane = t & 63, wr = wid >> 2, wc = wid & 3, fr = lane & 15, fq = lane >> 4;
    float ss[4];
#pragma unroll
    for (int m = 0; m < 4; ++m) { float a = 0.f;
#pragma unroll
        for (int n = 0; n < 4; ++n) a += h[m][n][0] * h[m][n][0] + h[m][n][1] * h[m][n][1] + h[m][n][2] * h[m][n][2] + h[m][n][3] * h[m][n][3];
        a += __shfl_xor(a, 16); a += __shfl_xor(a, 32); ss[m] = a; }
    if (fq == 0) {
#pragma unroll
        for (int m = 0; m < 4; ++m) red[(64 * wr + 16 * m + fr) * 4 + wc] = ss[m]; }
    __syncthreads();
    f32x4 mnv[4]; u32x2 owv[4][4];
#pragma unroll
    for (int n = 0; n < 4; ++n) mnv[n] = *(const f32x4*)(p.ml_norm + head * 256 + 64 * wc + 16 * n + 4 * fq);
#pragma unroll
    for (int m = 0; m < 4; ++m)
#pragma unroll
        for (int n = 0; n < 4; ++n) owv[m][n] = *(const u32x2*)(ob + (size_t)(64 * wr + 16 * m + fr) * 1024 + 64 * wc + 16 * n + 4 * fq);
#pragma unroll
    for (int m = 0; m < 4; ++m) { const int tl = 64 * wr + 16 * m + fr; const f32x4 rr = *(const f32x4*)(red + tl * 4);
        const float rstd = rsqrtf((rr[0] + rr[1] + rr[2] + rr[3]) * (1.f / 256.f) + 1e-6f);
#pragma unroll
        for (int n = 0; n < 4; ++n) { const int col = 64 * wc + 16 * n + 4 * fq; const f32x4 mn = mnv[n];
            const u32x2 ow = owv[m][n];
            u32x2 w; w.x = cvt_pk_bf16(h[m][n][0] * rstd * mn[0] * bf_lo(ow.x), h[m][n][1] * rstd * mn[1] * bf_hi(ow.x));
            w.y = cvt_pk_bf16(h[m][n][2] * rstd * mn[2] * bf_lo(ow.y), h[m][n][3] * rstd * mn[3] * bf_hi(ow.y));
            *(u32x2*)(omb + (size_t)tl * 1024 + col) = w; } }
    __syncthreads();
}
}

__global__ __launch_bounds__(512, 2) void mega(Params p) {
    extern __shared__ __attribute__((aligned(16))) unsigned char shm[];
    cg::grid_group grid = cg::this_grid();
    const int lo = p.phase_lo, hi = p.phase_hi, rm_ = p.rep_mask;
#ifndef REP_MASK
#define REP_MASK 0
#endif
#ifdef ONLY
#define PH(k) if ((k) == ONLY)
#else
#define PH(k) if (lo <= (k) && (k) < hi)
#endif
#define SYNC(k) if (lo <= (k) && (k) + 1 < hi) xcd_barrier(xbar)
    if (threadIdx.x < 4) ((LAS unsigned*)((LAS unsigned char*)shm + ST_OFF))[threadIdx.x] = 0u;
    __syncthreads();
    XcdBarrier xbar; xbar.bar = (unsigned*)(p.ws + OFF_BAR); xbar.x = 0; xbar.st = nullptr;
    if (hi > 100) grid.sync();
    if (hi - lo > 1) xbar = xcd_barrier_post((unsigned*)(p.ws + OFF_BAR), (volatile LAS unsigned*)((LAS unsigned char*)shm + ST_OFF));
    float* mod = (float*)(p.ws + OFF_MOD);
    bf16_t* hbuf = (bf16_t*)(p.out + (size_t)NTOK * 1024);
    bf16_t* act = (bf16_t*)(p.ws + OFF_Z);
    PH(0) { phase0(p, shm); }
    if (((REP_MASK >> 0) & 1) && ((rm_ >> 0) & 1)) PH(0) { phase0(p, shm); }
    SYNC(0);
    PH(1) { row_phase<0>(p, shm); }
    if (((REP_MASK >> 1) & 1) && ((rm_ >> 1) & 1)) PH(1) { row_phase<0>(p, shm); }
    SYNC(1);
    PH(2) { { EpiSwiglu E; E.O = act; run_gemm<4>(hbuf, (const bf16_t*)(p.ws + OFF_W1T), 5632, 1024, E, shm); if (gridDim.x > 64) { if (blockIdx.x >= 32) conv_items(p, shm, 0, 352 + (int)blockIdx.x - 32, 1296, (int)gridDim.x - 32); } else conv_items(p, shm, 0, 352 + (int)blockIdx.x, 1296, (int)gridDim.x);
        if (gridDim.x == 256 && blockIdx.x >= 32 && blockIdx.x < 176) conv_items(p, shm, 1, 384 + (int)blockIdx.x - 32, 528, 1 << 20); } }
    if (((REP_MASK >> 2) & 1) && ((rm_ >> 2) & 1)) PH(2) { { EpiSwiglu E; E.O = act; run_gemm<4>(hbuf, (const bf16_t*)(p.ws + OFF_W1T), 5632, 1024, E, shm); if (gridDim.x > 64) { if (blockIdx.x >= 32) conv_items(p, shm, 0, 352 + (int)blockIdx.x - 32, 1296, (int)gridDim.x - 32); } else conv_items(p, shm, 0, 352 + (int)blockIdx.x, 1296, (int)gridDim.x); } }
    SYNC(2);
    PH(3) { { EpiResid E; E.xa = p.x_prompt; E.xb = p.x_sample; E.xo = p.out; E.gate = mod + 2 * 1024; E.scale = 0.5f; run_gemm<GMT>(act, (const bf16_t*)(p.ws + OFF_W2T), 1024, 2816, E, shm); } }
    if (((REP_MASK >> 3) & 1) && ((rm_ >> 3) & 1)) PH(3) { { EpiResid E; E.xa = p.x_prompt; E.xb = p.x_sample; E.xo = p.out; E.gate = mod + 2 * 1024; E.scale = 0.5f; run_gemm<GMT>(act, (const bf16_t*)(p.ws + OFF_W2T), 1024, 2816, E, shm); } }
    SYNC(3);
    PH(4) { row_phase<1>(p, shm); }
    if (((REP_MASK >> 4) & 1) && ((rm_ >> 4) & 1)) PH(4) { row_phase<1>(p, shm); }
    SYNC(4);
    PH(5) { {
        if (gridDim.x == 256) { if (blockIdx.x >= 192) for (int it = (int)blockIdx.x - 192; it < 192; it += 64) ml::m1_pair(p, it, shm); }
        else for (int it = blockIdx.x; it < 192; it += gridDim.x) ml::m1_pair(p, it, shm);
        __syncthreads();
        EpiZ E; E.zbase = p.ws + OFF_Z; E.binp = (const float*)(p.ws + OFF_BINP); run_gemm<4>(hbuf, (const bf16_t*)(p.ws + OFF_WIN), 9216, 1024, E, shm);
        if (gridDim.x == 256 && blockIdx.x >= 192) conv_items(p, shm, 1, (int)blockIdx.x - 192, 256, 64);
    } }
    if (((REP_MASK >> 5) & 1) && ((rm_ >> 5) & 1)) PH(5) { {
        if (gridDim.x == 256) { if (blockIdx.x >= 192) for (int it = (int)blockIdx.x - 192; it < 192; it += 64) ml::m1_pair(p, it, shm); }
        else for (int it = blockIdx.x; it < 192; it += gridDim.x) ml::m1_pair(p, it, shm);
        __syncthreads();
        EpiZ E; E.zbase = p.ws + OFF_Z; E.binp = (const float*)(p.ws + OFF_BINP); run_gemm<4>(hbuf, (const bf16_t*)(p.ws + OFF_WIN), 9216, 1024, E, shm);
    } }
    SYNC(5);
    PH(6) { { ml::chain_table(p, shm);
        if (gridDim.x == 256) { const int b = blockIdx.x;
            if (b >= 128) { const int c = b - 128; ml::out_item(p, 2 * ((c & 7) * 8 + (c >> 4)) + ((c >> 3) & 1), shm); ml::m2_item(p, 640 + c, shm); conv_items(p, shm, 1, 256 + c, 384, 1 << 20); }
            else { for (int k = 0; k < 5; ++k) ml::m2_item(p, b + 128 * k, shm); } }
        else for (int it = blockIdx.x; it < 768; it += gridDim.x) ml::m2_item(p, it, shm); ml::conv_phase(p); } }
    if (((REP_MASK >> 6) & 1) && ((rm_ >> 6) & 1)) PH(6) { { ml::chain_table(p, shm);
        if (gridDim.x == 256) { const int b = blockIdx.x;
            for (int r = 0; r < 3; ++r) { const int group = r * 64 + (b & 7) * 8 + (b >> 5), member = (b >> 3) & 3, cgk = group >> 2, head = group & 3, dh = (member >> 1) * 4 + head; ml::m2_item(p, cgk * 16 + dh * 2 + (member & 1), shm); } }
        else for (int it = blockIdx.x; it < 768; it += gridDim.x) ml::m2_item(p, it, shm);  } }
    SYNC(6);
    PH(7) { ml::m3_phase(p); }
    if (((REP_MASK >> 7) & 1) && ((rm_ >> 7) & 1)) PH(7) { ml::m3_phase(p); }
    SYNC(7);
    PH(8) { { ml::chain_table(p, shm);
        if (gridDim.x == 256) { const int b = blockIdx.x;
            ml::out_item(p, 128 + 2 * ((b & 7) * 16 + (b >> 4)) + ((b >> 3) & 1), shm); }
        else for (int it = (int)gridDim.x - 1 - (int)blockIdx.x + 0; it < 384; it += gridDim.x) ml::out_item(p, 383 - it, shm);
        if (gridDim.x != 256) conv_items(p, shm, 1, (int)blockIdx.x, 528, (int)gridDim.x); } }
    if (((REP_MASK >> 8) & 1) && ((rm_ >> 8) & 1)) PH(8) { { ml::chain_table(p, shm);
        if (gridDim.x == 256) { const int b = blockIdx.x;
            ml::out_item(p, 128 + 2 * ((b & 7) * 16 + (b >> 4)) + ((b >> 3) & 1), shm);
            if (b >= 128) { const int c = b - 128; ml::out_item(p, 2 * ((c & 7) * 8 + (c >> 4)) + ((c >> 3) & 1), shm); } }
        else for (int it = (int)gridDim.x - 1 - (int)blockIdx.x + 0; it < 384; it += gridDim.x) ml::out_item(p, 383 - it, shm);
        if (gridDim.x == 256) { if (blockIdx.x < 128) conv_items(p, shm, 1, (int)blockIdx.x, 528, 128); }
        else conv_items(p, shm, 1, (int)blockIdx.x, 528, (int)gridDim.x); } }
    SYNC(8);
    PH(9) { {
        { EpiY<0> E; E.gate = zbuf(p, 6); E.Y = zbuf(p, 1); run_gemm<GMT>(zbuf(p, 0), (const bf16_t*)(p.ws + OFF_WML), 1024, 1024, E, shm); }
        { EpiY<1> E; E.gate = zbuf(p, 7); E.Y = zbuf(p, 1); run_gemm<GMT>(zbuf(p, 4), (const bf16_t*)(p.ws + OFF_WSC), 1024, 1024, E, shm); }
    } }
    if (((REP_MASK >> 9) & 1) && ((rm_ >> 9) & 1)) PH(9) { {
        { EpiY<0> E; E.gate = zbuf(p, 6); E.Y = zbuf(p, 1); run_gemm<GMT>(zbuf(p, 0), (const bf16_t*)(p.ws + OFF_WML), 1024, 1024, E, shm); }
        { EpiY<1> E; E.gate = zbuf(p, 7); E.Y = zbuf(p, 1); run_gemm<GMT>(zbuf(p, 4), (const bf16_t*)(p.ws + OFF_WSC), 1024, 1024, E, shm); }
    } }
    SYNC(9);
    PH(10) { {
        EpiResid E; E.xa = p.out; E.xb = p.out + (size_t)NPR * 1024; E.xo = p.out; E.gate = mod + 5 * 1024; E.scale = 1.0f; run_gemm<GMT>(zbuf(p, 1), (const bf16_t*)(p.ws + OFF_WO), 1024, 1024, E, shm);
    } }
    if (((REP_MASK >> 10) & 1) && ((rm_ >> 10) & 1)) PH(10) { {
        EpiResid E; E.xa = p.out; E.xb = p.out + (size_t)NPR * 1024; E.xo = p.out; E.gate = mod + 5 * 1024; E.scale = 1.0f; run_gemm<GMT>(zbuf(p, 1), (const bf16_t*)(p.ws + OFF_WO), 1024, 1024, E, shm);
    } }
    SYNC(10);
    PH(11) { row_phase<2>(p, shm); }
    if (((REP_MASK >> 11) & 1) && ((rm_ >> 11) & 1)) PH(11) { row_phase<2>(p, shm); }
    SYNC(11);
    PH(12) { { EpiSwiglu E; E.O = act; run_gemm<4>(zbuf(p, 7), (const bf16_t*)(p.ws + OFF_F2), 5632, 1024, E, shm); } }
    if (((REP_MASK >> 12) & 1) && ((rm_ >> 12) & 1)) PH(12) { { EpiSwiglu E; E.O = act; run_gemm<4>(zbuf(p, 7), (const bf16_t*)(p.ws + OFF_F2), 5632, 1024, E, shm); } }
    SYNC(12);
    PH(13) { { EpiResid E; E.xa = p.out; E.xb = p.out + (size_t)NPR * 1024; E.xo = p.out; E.gate = mod + 8 * 1024; E.scale = 0.5f; run_gemm<GMT>(act, (const bf16_t*)(p.ws + OFF_F2 + 11 * MiB), 1024, 2816, E, shm); } }
    if (((REP_MASK >> 13) & 1) && ((rm_ >> 13) & 1)) PH(13) { { EpiResid E; E.xa = p.out; E.xb = p.out + (size_t)NPR * 1024; E.xo = p.out; E.gate = mod + 8 * 1024; E.scale = 0.5f; run_gemm<GMT>(act, (const bf16_t*)(p.ws + OFF_F2 + 11 * MiB), 1024, 2816, E, shm); } }
    SYNC(13);
    PH(14) row_phase<3>(p, shm);
}

extern "C" void kernel_launch(void* const* d_in, const int* in_sizes, int n_in, void* d_out, int out_size, void* d_ws, size_t ws_size, hipStream_t stream) {
    static int grid_blocks = 0;
    if (!grid_blocks) {
        int dev = 0, cus = 0, per_cu = 0;
        hipGetDevice(&dev);
        hipDeviceGetAttribute(&cus, hipDeviceAttributeMultiprocessorCount, dev);
        hipFuncSetAttribute((const void*)mega, hipFuncAttributeMaxDynamicSharedMemorySize, LDS_BYTES);
        hipOccupancyMaxActiveBlocksPerMultiprocessor(&per_cu, mega, 512, LDS_BYTES);
        if (per_cu < 1) { fprintf(stderr, "occupancy query returned %d\n", per_cu); per_cu = 1; }
        grid_blocks = cus * per_cu;
    }
    Params p{};
    const float** f = (const float**)&p;
    for (int i = 0; i < 23; ++i) f[i] = (const float*)d_in[i];
    p.out = (float*)d_out; p.ws = (unsigned char*)d_ws; p.rep_mask = REP_MASK;
#if COOP
    (void)hipMemsetAsync((unsigned char*)d_ws + OFF_BAR, 0, XCD_BAR_WORDS * 4, stream);
    p.phase_lo = 0; p.phase_hi = 15;
    void* args[] = {&p};
    hipError_t e = hipLaunchCooperativeKernel((void*)mega, dim3(grid_blocks), dim3(512), args, LDS_BYTES, stream);
    if (e != hipSuccess) fprintf(stderr, "cooperative launch failed: %s (grid %d)\n", hipGetErrorString(e), grid_blocks);
#else
    for (int ph = 0; ph < 15; ++ph) { p.phase_lo = ph; p.phase_hi = ph + 1; hipLaunchKernelGGL(mega, dim3(grid_blocks), dim3(512), LDS_BYTES, stream, p); }
#endif
}
```

```cpp
#include <hip/hip_runtime.h>
#include <hip/hip_cooperative_groups.h>
#include <cstdio>
namespace cg = cooperative_groups;
namespace pg8 {
#define PG8_LAS __attribute__((address_space(3)))
typedef unsigned short bf16_t;
typedef short bf16x8 __attribute__((ext_vector_type(8)));
typedef float f32x4 __attribute__((ext_vector_type(4)));
typedef unsigned u32x4 __attribute__((ext_vector_type(4)));
constexpr int BM = 256, BK = 64, HALF = 128, HTB = HALF * BK * 2  , STAGE_BYTES = 8 * HTB, NXCD = 8, WGM = 8;

__host__ __device__ __forceinline__ int lds_byte(int r, int c) { const int st = (r >> 4) * 2 + (c >> 5), rr = r & 15, cc = c & 31, ob = rr * 64 + cc * 2; return st * 1024 + (ob ^ (((ob >> 9) & 1) << 5)); }
__host__ __device__ __forceinline__ void stage_rc(int b, int& R, int& C) { const int st = b / 1024, sb = b % 1024, swz = sb ^ (((sb >> 9) & 1) << 5); R = (st >> 1) * 16 + swz / 64; C = (st & 1) * 32 + (swz % 64) / 2; }
__host__ __device__ __forceinline__ int perm32(int rho) { const int n = rho >> 4, i = rho & 15; return 8 * (i >> 2) + 4 * n + (i & 3); }

struct Unit { int pm, pn; };
struct Gemm { const bf16_t* A; const bf16_t* Bt; int M, N, K; };
struct StaticOrder {
    int nM, nN, nwg, G, c;
    __host__ __device__ void init(int M, int N, int G_, int c_, int rows = BM) { nM = M / rows; nN = N / BM; nwg = nM * nN; G = G_; c = c_; }
    __host__ __device__ bool next(int i, Unit& u) const {
        const long L = (long)i * G + c; if (L >= nwg) return false;
        int wgid = (int)L; { const int q = nwg / NXCD, r = nwg % NXCD, xcd = wgid % NXCD, off = wgid / NXCD; wgid = (xcd < r ? xcd * (q + 1) : r * (q + 1) + (xcd - r) * q) + off; }
        const int nig = WGM * nN, gid = wgid / nig, fm = gid * WGM, gsz = (nM - fm) < WGM ? (nM - fm) : WGM;
        u.pm = fm + ((wgid % nig) % gsz); u.pn = (wgid % nig) / gsz; return true;
    }
    __device__ __forceinline__ void a_ready(const Unit&) const {}
    __device__ __forceinline__ void done(const Unit&) const {}
};
__device__ __forceinline__ unsigned cvt_pk_bf16(float lo, float hi) { unsigned r; asm volatile("v_cvt_pk_bf16_f32 %0, %1, %2" : "=v"(r) : "v"(lo), "v"(hi)); return r; }
template <class Epi, class Sched, bool STAMP = false, int MT = 4>
__device__ __forceinline__ void gemm_phase(PG8_LAS unsigned char* lds, const Gemm g, const Sched& S, const Epi& E, unsigned long long* stamps) {
    const int tid = threadIdx.x, wid = __builtin_amdgcn_readfirstlane(tid >> 6), lane = tid & 63, wr = wid >> 2, wc = wid & 3, fr = lane & 15, fq = lane >> 4;
    const int K = g.K, nt = K / BK;
    int ts_lo = 0, ts_hi = 0, nts = 0; const unsigned long long rt_entry = STAMP ? (unsigned long long)wall_clock64() : 0ull;
#define PG8_STAMP() do { if (STAMP && wid == 0 && nts < 64) { const unsigned long long _c = (unsigned long long)clock64(); \
        ts_lo = (lane == nts) ? (int)(unsigned)_c : ts_lo; ts_hi = (lane == nts) ? (int)(unsigned)(_c >> 32) : ts_hi; ++nts; } } while (0)
    PG8_STAMP();
    unsigned voffA[2], voffB[2];
#pragma unroll
    for (int i = 0; i < 2; ++i) { int R, C; stage_rc(tid * 16 + i * 8192, R, C); const int Rb = Epi::PERM ? ((R & ~31) + perm32(R & 31)) : R;
        voffA[i] = (unsigned)(R * K + C) * 2u; voffB[i] = (unsigned)(Rb * K + C) * 2u; }
    const size_t kstep = (size_t)(BK * 2);
    const size_t hstep = (size_t)HALF * K * 2;
    const size_t tstep = 2 * hstep; const size_t hstepA = (size_t)(32 * MT) * K * 2, tstepA = 2 * hstepA;
    const unsigned ldsw = (unsigned)wid * 1024u;
    const int aoff = lds_byte(wr * 16 * MT + fr, fq * 8), boff = lds_byte(wc * 32 + fr, fq * 8);
#define PG8_SA(b, h) (((b) * 2 + (h)) * HTB)
#define PG8_SB(b, h) ((4 + (b) * 2 + (h)) * HTB)
#define PG8_STAGE(bufoff, gbase, voff) do { _Pragma("unroll") for (int _i = 0; _i < 2; ++_i) \
        __builtin_amdgcn_global_load_lds((const unsigned*)((const char*)(gbase) + (voff)[_i]), (PG8_LAS unsigned*)(lds + (bufoff) + ldsw + _i * 8192), 16, 0, 0); } while (0)
#define PG8_LDA(dst, b, h) do { _Pragma("unroll") for (int m = 0; m < MT; ++m) _Pragma("unroll") for (int k = 0; k < 2; ++k) dst[m][k] = *(const PG8_LAS bf16x8*)(lds + PG8_SA(b, h) + aoff + m * 2048 + k * 1024); } while (0)
#define PG8_LDB(dst, b, h) do { _Pragma("unroll") for (int n = 0; n < 2; ++n) _Pragma("unroll") for (int k = 0; k < 2; ++k) dst[n][k] = *(const PG8_LAS bf16x8*)(lds + PG8_SB(b, h) + boff + n * 2048 + k * 1024); } while (0)
#define PG8_MMA(ai, bj, At, Bt) do { __builtin_amdgcn_s_setprio(1); _Pragma("unroll") for (int m = 0; m < MT; ++m) _Pragma("unroll") for (int n = 0; n < 2; ++n) _Pragma("unroll") for (int k = 0; k < 2; ++k) \
        acc[ai][bj][m][n] = __builtin_amdgcn_mfma_f32_16x16x32_bf16(Bt[n][k], At[m][k], acc[ai][bj][m][n], 0, 0, 0); __builtin_amdgcn_s_setprio(0); } while (0)
#define PG8_WAIT_V(n) asm volatile("s_waitcnt vmcnt(" #n ")" ::: "memory")
#define PG8_WAIT_L(n) asm volatile("s_waitcnt lgkmcnt(" #n ")" ::: "memory")
#define PG8_BAR __builtin_amdgcn_s_barrier()
#define PG8_SCHED __builtin_amdgcn_sched_barrier(0)
    Unit cur, nxt; int ui = 0;
    if (!S.next(0, cur)) return;
    f32x4 acc[2][2][MT][2];
#pragma unroll
    for (int a = 0; a < 2; ++a)
#pragma unroll
        for (int b = 0; b < 2; ++b)
#pragma unroll
            for (int m = 0; m < MT; ++m)
#pragma unroll
                for (int n = 0; n < 2; ++n) acc[a][b][m][n] = (f32x4){0.f, 0.f, 0.f, 0.f};
    bf16x8 At[MT][2], B0[2][2], B1[2][2];
    const char* cA = (const char*)g.A + (size_t)cur.pm * tstepA; const char* cB = (const char*)g.Bt + (size_t)cur.pn * tstep;
    S.a_ready(cur);
    PG8_STAGE(PG8_SB(0, 0), cB, voffB); PG8_STAGE(PG8_SA(0, 0), cA, voffA); PG8_STAGE(PG8_SB(0, 1), cB + hstep, voffB); PG8_STAGE(PG8_SA(0, 1), cA + hstepA, voffA);
    if (wr == 1) PG8_BAR;
    PG8_WAIT_V(4); PG8_BAR;
    PG8_STAGE(PG8_SB(1, 0), cB + kstep, voffB); PG8_STAGE(PG8_SA(1, 0), cA + kstep, voffA); PG8_STAGE(PG8_SB(1, 1), cB + hstep + kstep, voffB);
    PG8_WAIT_V(6); PG8_BAR;
    PG8_STAMP();
    for (;;) {
        const bool has_next = S.next(ui + 1, nxt);
        const char* nA = has_next ? (const char*)g.A + (size_t)nxt.pm * tstepA : cA; const char* nB = has_next ? (const char*)g.Bt + (size_t)nxt.pn * tstep : cB;
        for (int t = 0; t < nt; t += 2) {
            const bool last = (t == nt - 2);
            const char* a1 = cA + (size_t)(t + 1) * kstep;
            const char* a2 = last ? nA : cA + (size_t)(t + 2) * kstep; const char* b2 = last ? nB : cB + (size_t)(t + 2) * kstep;
            const char* a3 = a2 + kstep; const char* b3 = b2 + kstep;
            if (last && has_next) S.a_ready(nxt);
            PG8_LDB(B0, 0, 0); PG8_SCHED; PG8_LDA(At, 0, 0); PG8_STAGE(PG8_SA(1, 1), a1 + hstepA, voffA);
            if constexpr (MT == 4) PG8_WAIT_L(8); else PG8_WAIT_L(6); PG8_BAR; PG8_WAIT_L(0); PG8_MMA(0, 0, At, B0); PG8_BAR; PG8_SCHED;
            PG8_LDB(B1, 0, 1); PG8_STAGE(PG8_SB(0, 0), b2, voffB);
            PG8_BAR; PG8_WAIT_L(0); PG8_MMA(0, 1, At, B1); PG8_BAR;
            PG8_LDA(At, 0, 1); PG8_STAGE(PG8_SA(0, 0), a2, voffA);
            PG8_BAR; PG8_WAIT_L(0); PG8_MMA(1, 0, At, B0); PG8_BAR; PG8_SCHED;
            PG8_STAGE(PG8_SB(0, 1), b2 + hstep, voffB);
            PG8_WAIT_V(6); PG8_BAR; PG8_MMA(1, 1, At, B1); PG8_BAR;
            PG8_LDB(B0, 1, 0); PG8_SCHED; PG8_LDA(At, 1, 0); PG8_STAGE(PG8_SA(0, 1), a2 + hstepA, voffA);
            if constexpr (MT == 4) PG8_WAIT_L(8); else PG8_WAIT_L(6); PG8_BAR; PG8_WAIT_L(0); PG8_MMA(0, 0, At, B0); PG8_BAR; PG8_SCHED;
            PG8_LDB(B1, 1, 1); PG8_STAGE(PG8_SB(1, 0), b3, voffB);
            PG8_BAR; PG8_WAIT_L(0); PG8_MMA(0, 1, At, B1); PG8_BAR;
            PG8_LDA(At, 1, 1); PG8_STAGE(PG8_SA(1, 0), a3, voffA);
            PG8_BAR; PG8_WAIT_L(0); PG8_MMA(1, 0, At, B0); PG8_BAR; PG8_SCHED;
            PG8_STAGE(PG8_SB(1, 1), b3 + hstep, voffB);
            PG8_WAIT_V(6); PG8_BAR; PG8_MMA(1, 1, At, B1); PG8_BAR;
        }
        PG8_STAMP();
        if constexpr (!Epi::AFTER_DRAIN) { E(acc, cur, wr, wc, fr, fq); S.done(cur); }
        PG8_STAMP();
        if (!has_next) break;
#pragma unroll
        for (int a = 0; a < 2; ++a)
#pragma unroll
            for (int b = 0; b < 2; ++b)
#pragma unroll
                for (int m = 0; m < MT; ++m)
#pragma unroll
                    for (int n = 0; n < 2; ++n) acc[a][b][m][n] = (f32x4){0.f, 0.f, 0.f, 0.f};
        cur = nxt; cA = nA; cB = nB; ++ui;
    }
    PG8_WAIT_V(0);
    if (wr == 0) PG8_BAR;
    PG8_BAR;
    if constexpr (Epi::AFTER_DRAIN) { E.fused(acc, cur, wr, wc, fr, fq, lds, wid, lane); S.done(cur); }
    PG8_STAMP();
    if (STAMP && wid == 0) { stamps[lane] = lane < nts ? (((unsigned long long)(unsigned)ts_hi << 32) | (unsigned)ts_lo) : 0ull;
        if (lane == 62) stamps[62] = rt_entry; if (lane == 63) stamps[63] = (unsigned long long)wall_clock64(); }
#undef PG8_STAMP
#undef PG8_SA
#undef PG8_SB
#undef PG8_STAGE
#undef PG8_LDA
#undef PG8_LDB
#undef PG8_MMA
#undef PG8_WAIT_V
#undef PG8_WAIT_L
#undef PG8_BAR
#undef PG8_SCHED
}
}
using pg8::bf16_t; using pg8::bf16x8; using pg8::f32x4; using pg8::u32x4; using pg8::cvt_pk_bf16; using pg8::Unit;
typedef unsigned u32x2 __attribute__((ext_vector_type(2)));
#define DEVI __device__ __forceinline__
#define LBAR() do { asm volatile("s_waitcnt lgkmcnt(0)" ::: "memory"); __builtin_amdgcn_s_barrier(); asm volatile("" ::: "memory"); } while (0)
#define LAS __attribute__((address_space(3)))
#define XB_TMO      128
#define XB_XCNT(j)  (256  + 64 * (j))
#define XB_XSUB(j)  (1280 + 64 * (j))
#define XB_XGEN(j)  (2304 + 64 * (j))
#define XB_TOP      3328
#define XB_TOPGEN   3392
#define XCD_BAR_WORDS 3456
#define XB_SPIN_CAP (1u << 18)

__device__ __forceinline__ unsigned xb_ld(unsigned* p)              { return __hip_atomic_load(p, __ATOMIC_RELAXED, __HIP_MEMORY_SCOPE_AGENT); }
__device__ __forceinline__ unsigned xb_add(unsigned* p, unsigned v) { return __hip_atomic_fetch_add(p, v, __ATOMIC_RELAXED, __HIP_MEMORY_SCOPE_AGENT); }
__device__ __forceinline__ unsigned xb_xcc_id() { return (unsigned)__builtin_amdgcn_s_getreg((3 << 11) | 20) & 0xFu; }
#define XB_SPIN(cond, bar) do { unsigned _sp = 0; while (cond) { __builtin_amdgcn_s_sleep(1); \
    if ((++_sp & 255u) == 0u) { if (xb_ld(&(bar)[XB_TMO])) break; if (_sp > XB_SPIN_CAP) { atomicAdd(&(bar)[XB_TMO], 1u); break; } } } } while (0)

struct XcdBarrier {
    unsigned* bar; unsigned x;
    volatile LAS unsigned* st;
};

__device__ __forceinline__ XcdBarrier xcd_barrier_post(unsigned* bar, volatile LAS unsigned* st) {
    XcdBarrier b; b.bar = bar; b.x = xb_xcc_id(); b.st = st;
    if (threadIdx.x == 0) (void)xb_add(&bar[XB_XCNT(b.x)], 1u);
    return b;
}
__device__ __forceinline__ void xcd_barrier_complete(unsigned* bar, unsigned x, unsigned& nloc, unsigned& nx) {
    const unsigned G = gridDim.x * gridDim.y * gridDim.z;
    unsigned sum, cnt, mine, sp = 0u;
    for (;;) {
        sum = 0u; cnt = 0u; mine = 0u;
#pragma unroll
        for (unsigned j = 0; j < 16; ++j) { const unsigned c = xb_ld(&bar[XB_XCNT(j)]); sum += c; cnt += (c > 0u) ? 1u : 0u; mine = (j == x) ? c : mine; }
        if (sum == G) break;
        __builtin_amdgcn_s_sleep(1);
        if ((++sp & 255u) == 0u) { if (xb_ld(&bar[XB_TMO])) break; if (sp > XB_SPIN_CAP) { atomicAdd(&bar[XB_TMO], 1u); break; } }
    }
    nloc = mine > 0u ? mine : 1u; nx = cnt > 0u ? cnt : 1u;
}

__device__ __forceinline__ void xcd_barrier(const XcdBarrier& b) {
    asm volatile("s_waitcnt vmcnt(0)" ::: "memory");
    __syncthreads();
    if (threadIdx.x == 0) {
        unsigned* bar = b.bar;
        __builtin_amdgcn_s_waitcnt(0);
        unsigned nloc = b.st[0], nx = b.st[1];
        if (nloc == 0u) { xcd_barrier_complete(bar, b.x, nloc, nx); b.st[0] = nloc; b.st[1] = nx; }
        const unsigned old = xb_add(&bar[XB_XSUB(b.x)], 1u);
        const unsigned gen = old / nloc;
        if (old + 1u == (gen + 1u) * nloc) {
            __builtin_amdgcn_fence(__ATOMIC_RELEASE, "agent");
            asm volatile("s_waitcnt vmcnt(0)" ::: "memory");
            const unsigned og = xb_add(&bar[XB_TOP], 1u);
            const unsigned tg = og / nx;
            if (og + 1u == (tg + 1u) * nx) xb_add(&bar[XB_TOPGEN], 1u);
            else XB_SPIN(xb_ld(&bar[XB_TOPGEN]) == tg, bar);
            __builtin_amdgcn_fence(__ATOMIC_ACQUIRE, "agent");
            xb_add(&bar[XB_XGEN(b.x)], 1u);
            asm volatile("s_waitcnt vmcnt(0)" ::: "memory");
        } else {
            XB_SPIN(xb_ld(&bar[XB_XGEN(b.x)]) == gen, bar);
            __builtin_amdgcn_fence(__ATOMIC_ACQUIRE, "agent");
            asm volatile("s_waitcnt vmcnt(0)" ::: "memory");
        }
    }
    __syncthreads();
}


#ifndef GMT
#define GMT 3
#endif
#ifndef COOP
#define COOP 1
#endif

constexpr int NTOK = 12288, NPR = 4096;
constexpr size_t MiB = (size_t)1 << 20, KiB = 1024;
constexpr size_t OFF_W1T = 0, OFF_W2T = 11 * MiB, OFF_WIN = 16 * MiB + 512 * KiB, OFF_CIN = 0;
constexpr size_t OFF_WML = 34 * MiB + 512 * KiB, OFF_WSC = OFF_WML + 2 * MiB, OFF_WO = OFF_WSC + 2 * MiB;
constexpr size_t OFF_MOD = 40 * MiB + 512 * KiB, OFF_BINP = OFF_MOD + 112 * KiB, OFF_GATES = OFF_BINP + 40 * KiB;
constexpr size_t OFF_BQ = OFF_GATES + 768 * KiB, OFF_GI = OFF_BQ + 384 * KiB, OFF_PMX = OFF_GI + 384 * KiB;
constexpr size_t OFF_BL = OFF_PMX + 384 * KiB, OFF_MLOC = OFF_BL + 4 * KiB, OFF_DN = OFF_MLOC + 4 * KiB;
constexpr size_t OFF_BAR = OFF_DN + 384 * KiB;
constexpr size_t OFF_Z = 44 * MiB, TB = 24 * MiB;
constexpr size_t OFF_F2 = 236 * MiB;
constexpr int ST_OFF = 161792;
constexpr int LDS_BYTES = 162048;

struct Params {
    const float *x_prompt, *x_sample, *state_C, *state_n, *state_m, *c, *c_ctx, *w_mod, *b_mod, *norm_g, *ffn1_w1, *ffn1_w2, *w_in, *b_in,
        *conv_w, *conv_b, *ml_norm, *w_ml_out, *w_sc_out, *w_o, *ffn2_w1, *ffn2_w2, *final_norm;
    float* out; unsigned char* ws; int phase_lo, phase_hi, rep_mask, pad_;
};

DEVI float bf2f(unsigned short b) { return __uint_as_float(((unsigned)b) << 16); }
DEVI float bf_lo(unsigned u) { return __uint_as_float(u << 16); }
DEVI float bf_hi(unsigned u) { return __uint_as_float(u & 0xffff0000u); }
DEVI unsigned short f2bf(float f) { return (unsigned short)(cvt_pk_bf16(f, f) & 0xffffu); }
DEVI float sigm(float x) { return 1.f / (1.f + __expf(-x)); }
DEVI float silu(float x) { return x / (1.f + __expf(-x)); }
DEVI int cond_of_row(int row) { return row < NPR ? 0 : 1 + ((row - NPR) >> 12); }
DEVI bf16_t* zbuf(const Params& p, int i) { return (bf16_t*)(p.ws + OFF_Z + (size_t)i * TB); }
DEVI float wave_sum(float v) { v += __shfl_xor(v, 32); v += __shfl_xor(v, 16); v += __shfl_xor(v, 8); v += __shfl_xor(v, 4); v += __shfl_xor(v, 2); v += __shfl_xor(v, 1); return v; }

DEVI int win_src_col(int L) {
    if (L < 4096) return L;
    if (L < 5120) return 4112 + (L - 4096);
    if (L < 7168) { const int o = L - 5120, j = o >> 8, w = o & 255; return (w < 128) ? (5136 + 128 * j + w) : (6160 + 128 * j + (w - 128)); }
    if (L < 8192) return 7184 + (L - 7168);
    return 8208 + (L - 8192);
}
DEVI int w1_src_col(int L) { const int j = L >> 8, w = L & 255; return (w < 128) ? (128 * j + w) : (2816 + 128 * j + (w - 128)); }

DEVI void conv_tile(const float* __restrict__ src, int ldsrc, int col0, bf16_t* __restrict__ dst, int Ktot, int L0, int k0, unsigned char* shm) {
    unsigned short* T = (unsigned short*)shm;
    const int t = threadIdx.x, nq = t & 15, kr = t >> 4;
#pragma unroll
    for (int ps = 0; ps < 8; ++ps) { const int k = ps * 32 + kr; const f32x4 v4_ = __builtin_nontemporal_load((const f32x4*)(src + (size_t)(k0 + k) * ldsrc + col0 + 4 * nq)); float4 v; v.x = v4_[0]; v.y = v4_[1]; v.z = v4_[2]; v.w = v4_[3];
        T[(4 * nq + 0) * 258 + k] = f2bf(v.x); T[(4 * nq + 1) * 258 + k] = f2bf(v.y); T[(4 * nq + 2) * 258 + k] = f2bf(v.z); T[(4 * nq + 3) * 258 + k] = f2bf(v.w); }
    __syncthreads();
#pragma unroll
    for (int ps = 0; ps < 4; ++ps) { const int n = ps * 16 + (t >> 5), k8 = (t & 31) * 8; const unsigned* s = (const unsigned*)(T + n * 258 + k8);
        u32x4 w; w.x = s[0]; w.y = s[1]; w.z = s[2]; w.w = s[3]; *(u32x4*)(dst + (size_t)(L0 + n) * Ktot + k0 + k8) = w; }
    __syncthreads();
}
DEVI void conv_ffn(const float* w1, const float* w2, size_t off, const Params& p, int it, unsigned char* shm) {
    if (it < 352) { const int nb = it >> 2, kb = it & 3; conv_tile(w1, 5632, w1_src_col(64 * nb), (bf16_t*)(p.ws + off), 1024, 64 * nb, 256 * kb, shm); }
    else { const int i2 = it - 352, nb = i2 / 11, kb = i2 % 11; conv_tile(w2, 1024, 64 * nb, (bf16_t*)(p.ws + off + 11 * MiB), 2816, 64 * nb, 256 * kb, shm); }
}
struct ConvDesc { const float* src; bf16_t* dst; int ldsrc, col0, Ktot, L0, k0; };
DEVI ConvDesc conv_desc(const Params& p, int list, int it) {
    ConvDesc d;
    if (it < 352) { const int nb = it >> 2, kb = it & 3; d.src = list ? p.ffn2_w1 : p.ffn1_w1; d.ldsrc = 5632; d.col0 = w1_src_col(64 * nb); d.dst = (bf16_t*)(p.ws + (list ? OFF_F2 : OFF_W1T)); d.Ktot = 1024; d.L0 = 64 * nb; d.k0 = 256 * kb; }
    else if (it < 528) { const int i2 = it - 352, nb = i2 / 11, kb = i2 % 11; d.src = list ? p.ffn2_w2 : p.ffn1_w2; d.ldsrc = 1024; d.col0 = 64 * nb; d.dst = (bf16_t*)(p.ws + (list ? OFF_F2 : OFF_W1T) + 11 * MiB); d.Ktot = 2816; d.L0 = 64 * nb; d.k0 = 256 * kb; }
    else if (it < 1104) { const int i2 = it - 528, nb = i2 >> 2, kb = i2 & 3; d.src = p.w_in; d.ldsrc = 9232; d.col0 = win_src_col(64 * nb); d.dst = (bf16_t*)(p.ws + OFF_WIN); d.Ktot = 1024; d.L0 = 64 * nb; d.k0 = 256 * kb; }
    else { const int i2 = it - 1104, mtx = i2 >> 6, i3 = i2 & 63, nb = i3 >> 2, kb = i3 & 3;
        d.src = mtx == 0 ? p.w_ml_out : (mtx == 1 ? p.w_sc_out : p.w_o); d.dst = (bf16_t*)(p.ws + (mtx == 0 ? OFF_WML : (mtx == 1 ? OFF_WSC : OFF_WO)));
        d.ldsrc = 1024; d.col0 = 64 * nb; d.Ktot = 1024; d.L0 = 64 * nb; d.k0 = 256 * kb; }
    return d;
}
DEVI void conv_load(f32x4 (&r)[8], const ConvDesc& d) {
    const int t = threadIdx.x, nq = t & 15, kp = t >> 4;
#pragma unroll
    for (int ps = 0; ps < 4; ++ps) { const float* s = d.src + (size_t)(d.k0 + ps * 64 + 2 * kp) * d.ldsrc + d.col0 + 4 * nq;
        r[2 * ps] = __builtin_nontemporal_load((const f32x4*)s); r[2 * ps + 1] = __builtin_nontemporal_load((const f32x4*)(s + d.ldsrc)); }
}
DEVI void conv_items(const Params& p, unsigned char* shm, int list, int first, int end, int stride) {
    if (first >= end) return;
    unsigned* T = (unsigned*)shm;
    const int t = threadIdx.x, nq = t & 15, kp = t >> 4;
    f32x4 r[8];
    ConvDesc d = conv_desc(p, list, first); conv_load(r, d);
#pragma unroll 1
    for (int it = first; it < end; it += stride) {
#pragma unroll
        for (int ps = 0; ps < 4; ++ps)
#pragma unroll
            for (int j = 0; j < 4; ++j) T[(4 * nq + j) * 129 + ps * 32 + kp] = cvt_pk_bf16(r[2 * ps][j], r[2 * ps + 1][j]);
        __syncthreads();
        ConvDesc dn = d; const bool hn = it + stride < end;
        if (hn) { dn = conv_desc(p, list, it + stride); conv_load(r, dn); }
#pragma unroll
        for (int ps = 0; ps < 4; ++ps) { const int n = ps * 16 + (t >> 5), k8 = (t & 31) * 8; const unsigned* s = T + n * 129 + (k8 >> 1);
            u32x4 w; w.x = s[0]; w.y = s[1]; w.z = s[2]; w.w = s[3]; *(u32x4*)(d.dst + (size_t)(d.L0 + n) * d.Ktot + d.k0 + k8) = w; }
        __syncthreads();
        d = dn;
    }
}
DEVI void phase0(const Params& p, unsigned char* shm) {
    const int t = threadIdx.x;
    float* mod = (float*)(p.ws + OFF_MOD);
    {
        float* sc = (float*)shm; float* red = sc + 3072;
        for (int i = t; i < 3072; i += 512) { const int b = i >> 10, k = i & 1023; const float v = (b == 0) ? p.c_ctx[k] : p.c[(b - 1) * 1024 + k]; sc[i] = silu(v); }
        __syncthreads();
        for (int it = blockIdx.x; it < 144; it += gridDim.x) {
            const int n0 = it * 64, nq = t & 15, kg = t >> 4;
            f32x4 a0 = {0.f, 0.f, 0.f, 0.f}, a1 = a0, a2 = a0;
#pragma unroll 8
            for (int kk = 0; kk < 32; ++kk) { const int k = kg * 32 + kk; const f32x4 w = __builtin_nontemporal_load((const f32x4*)(p.w_mod + (size_t)k * 9216 + n0 + 4 * nq));
                a0 += sc[k] * w; a1 += sc[1024 + k] * w; a2 += sc[2048 + k] * w; }
            *(f32x4*)(red + (kg * 3 + 0) * 64 + 4 * nq) = a0; *(f32x4*)(red + (kg * 3 + 1) * 64 + 4 * nq) = a1; *(f32x4*)(red + (kg * 3 + 2) * 64 + 4 * nq) = a2;
            __syncthreads();
            if (t < 192) { const int b = t >> 6, n = t & 63; float s = 0.f;
#pragma unroll
                for (int g = 0; g < 32; ++g) s += red[(g * 3 + b) * 64 + n];
                mod[b * 9216 + n0 + n] = s + p.b_mod[n0 + n]; }
            __syncthreads();
        }
    }
    {
        float* binp = (float*)(p.ws + OFF_BINP);
        for (int i = blockIdx.x * 512 + t; i < 9216; i += gridDim.x * 512) binp[i] = p.b_in[win_src_col(i)];
    }
    if (gridDim.x == 256) {
        const int b = blockIdx.x;
        if (b >= 144) conv_items(p, shm, 0, b - 144, 224, 112); else if (b < 128) conv_items(p, shm, 0, 224 + b, 352, 128);
    } else conv_items(p, shm, 0, (int)blockIdx.x, 352, (int)gridDim.x);
}
DEVI void conv_rest(const Params& p, unsigned char* shm, int first, int stride) {
    for (int it = 352 + first; it < 1296; it += stride) {
        if (it < 528) conv_ffn(p.ffn1_w1, p.ffn1_w2, OFF_W1T, p, it, shm);
        else if (it < 1104) { const int i2 = it - 528, nb = i2 >> 2, kb = i2 & 3; conv_tile(p.w_in, 9232, win_src_col(64 * nb), (bf16_t*)(p.ws + OFF_WIN), 1024, 64 * nb, 256 * kb, shm); }
        else { const int i2 = it - 1104, mtx = i2 >> 6, i3 = i2 & 63, nb = i3 >> 2, kb = i3 & 3;
            const float* src = mtx == 0 ? p.w_ml_out : (mtx == 1 ? p.w_sc_out : p.w_o);
            bf16_t* dst = (bf16_t*)(p.ws + (mtx == 0 ? OFF_WML : (mtx == 1 ? OFF_WSC : OFF_WO)));
            conv_tile(src, 1024, 64 * nb, dst, 1024, 64 * nb, 256 * kb, shm); }
    }
}

template <int MODE> DEVI void row_phase(const Params& p, unsigned char* shm) {
    const int t = threadIdx.x, wid = t >> 6, lane = t & 63;
    const float* mod = (const float*)(p.ws + OFF_MOD);
    float* WgT = (float*)shm;
    if (MODE == 1) {
        for (int i = t; i < 16384; i += 512) { const int k = i >> 4, g = i & 15; WgT[g * 1024 + k] = p.w_in[(size_t)k * 9232 + 4096 + g]; }
        __syncthreads();
    }
    const float* gvec = MODE == 3 ? p.final_norm : p.norm_g + MODE * 1024;
    bf16_t* hout = MODE == 2 ? zbuf(p, 7) : (bf16_t*)(p.out + (size_t)NTOK * 1024);
    float* gates = (float*)(p.ws + OFF_GATES);
    f32x4 gv[4];
#pragma unroll
    for (int i = 0; i < 4; ++i) gv[i] = *(const f32x4*)(gvec + i * 256 + 4 * lane);
    if (MODE == 1) {
        const int stride = gridDim.x * 8;
        for (int rowA = blockIdx.x * 8 + wid; rowA < NTOK; rowA += 2 * stride) {
            const int rowB = rowA + stride; const bool hasB = rowB < NTOK; const int rB = hasB ? rowB : rowA;
            f32x4 va[4], vb[4]; float ssa = 0.f, ssb = 0.f;
#pragma unroll
            for (int i = 0; i < 4; ++i) { va[i] = *(const f32x4*)(p.out + (size_t)rowA * 1024 + i * 256 + 4 * lane); vb[i] = *(const f32x4*)(p.out + (size_t)rB * 1024 + i * 256 + 4 * lane); }
            f32x4 sa[4], ha[4], sb[4], hb[4];
            { const float* sh = mod + cond_of_row(rowA) * 9216 + 3 * 1024; const float* sh2 = mod + cond_of_row(rB) * 9216 + 3 * 1024;
#pragma unroll
              for (int i = 0; i < 4; ++i) { ha[i] = *(const f32x4*)(sh + i * 256 + 4 * lane); sa[i] = *(const f32x4*)(sh + 1024 + i * 256 + 4 * lane); hb[i] = *(const f32x4*)(sh2 + i * 256 + 4 * lane); sb[i] = *(const f32x4*)(sh2 + 1024 + i * 256 + 4 * lane); } }
#pragma unroll
            for (int i = 0; i < 4; ++i) { ssa += va[i][0] * va[i][0] + va[i][1] * va[i][1] + va[i][2] * va[i][2] + va[i][3] * va[i][3]; ssb += vb[i][0] * vb[i][0] + vb[i][1] * vb[i][1] + vb[i][2] * vb[i][2] + vb[i][3] * vb[i][3]; }
            ssa = wave_sum(ssa); ssb = wave_sum(ssb);
            const float ra = rsqrtf(ssa * (1.f / 1024.f) + 1e-6f), rb = rsqrtf(ssb * (1.f / 1024.f) + 1e-6f);
#pragma unroll
            for (int i = 0; i < 4; ++i) { va[i] = va[i] * ra * gv[i] * (1.f + sa[i]) + ha[i]; vb[i] = vb[i] * rb * gv[i] * (1.f + sb[i]) + hb[i];
                u32x2 w; w.x = cvt_pk_bf16(va[i][0], va[i][1]); w.y = cvt_pk_bf16(va[i][2], va[i][3]); *(u32x2*)(hout + (size_t)rowA * 1024 + i * 256 + 4 * lane) = w;
                if (hasB) { u32x2 w2; w2.x = cvt_pk_bf16(vb[i][0], vb[i][1]); w2.y = cvt_pk_bf16(vb[i][2], vb[i][3]); *(u32x2*)(hout + (size_t)rowB * 1024 + i * 256 + 4 * lane) = w2; } }
            float pa[16], pb[16];
#pragma unroll
            for (int g = 0; g < 16; ++g) { float a = 0.f, b = 0.f;
#pragma unroll
                for (int i = 0; i < 4; ++i) { const f32x4 w4 = *(const f32x4*)(WgT + g * 1024 + i * 256 + 4 * lane);
                    a += va[i][0] * w4[0] + va[i][1] * w4[1] + va[i][2] * w4[2] + va[i][3] * w4[3]; b += vb[i][0] * w4[0] + vb[i][1] * w4[1] + vb[i][2] * w4[2] + vb[i][3] * w4[3]; }
                pa[g] = a; pb[g] = b; }
#define TRED(x, res) do { float b8[8], c4[4], d2[2]; bool up = (lane & 32) != 0; \
                _Pragma("unroll") for (int g = 0; g < 8; ++g) { const float snd = up ? x[g] : x[g + 8], kp = up ? x[g + 8] : x[g]; b8[g] = kp + __shfl_xor(snd, 32); } \
                up = (lane & 16) != 0; _Pragma("unroll") for (int g = 0; g < 4; ++g) { const float snd = up ? b8[g] : b8[g + 4], kp = up ? b8[g + 4] : b8[g]; c4[g] = kp + __shfl_xor(snd, 16); } \
                up = (lane & 8) != 0; _Pragma("unroll") for (int g = 0; g < 2; ++g) { const float snd = up ? c4[g] : c4[g + 2], kp = up ? c4[g + 2] : c4[g]; d2[g] = kp + __shfl_xor(snd, 8); } \
                up = (lane & 4) != 0; { const float snd = up ? d2[0] : d2[1], kp = up ? d2[1] : d2[0]; res = kp + __shfl_xor(snd, 4); } \
                res += __shfl_xor(res, 2); res += __shfl_xor(res, 1); } while (0)
            float ea, eb; TRED(pa, ea); TRED(pb, eb);
#undef TRED
            const int gidx = ((lane >> 5) & 1) * 8 + ((lane >> 4) & 1) * 4 + ((lane >> 3) & 1) * 2 + ((lane >> 2) & 1);
            if ((lane & 3) == 0) { const float bi = p.b_in[4096 + gidx]; gates[(size_t)rowA * 16 + gidx] = ea + bi; if (hasB) gates[(size_t)rowB * 16 + gidx] = eb + bi; }
        }
    } else
    for (int row = blockIdx.x * 8 + wid; row < NTOK; row += gridDim.x * 8) {
        const float* src = (MODE == 0) ? (row < NPR ? p.x_prompt + (size_t)row * 1024 : p.x_sample + (size_t)(row - NPR) * 1024) : p.out + (size_t)row * 1024;
        f32x4 v[4]; float ss = 0.f;
#pragma unroll
        for (int i = 0; i < 4; ++i) { v[i] = *(const f32x4*)(src + i * 256 + 4 * lane); ss += v[i][0] * v[i][0] + v[i][1] * v[i][1] + v[i][2] * v[i][2] + v[i][3] * v[i][3]; }
        ss = wave_sum(ss);
        const float rstd = rsqrtf(ss * (1.f / 1024.f) + 1e-6f);
        if (MODE == 3) {
#pragma unroll
            for (int i = 0; i < 4; ++i) *(f32x4*)(p.out + (size_t)row * 1024 + i * 256 + 4 * lane) = v[i] * rstd * gv[i];
        } else {
            const int b = cond_of_row(row);
            const float* sh = mod + b * 9216 + (MODE * 3) * 1024; const float* scl = sh + 1024;
            f32x4 s4v[4], h4v[4];
#pragma unroll
            for (int i = 0; i < 4; ++i) { s4v[i] = *(const f32x4*)(scl + i * 256 + 4 * lane); h4v[i] = *(const f32x4*)(sh + i * 256 + 4 * lane); }
#pragma unroll
            for (int i = 0; i < 4; ++i) { const f32x4 s4 = s4v[i], h4 = h4v[i];
                v[i] = v[i] * rstd * gv[i] * (1.f + s4) + h4;
                u32x2 w; w.x = cvt_pk_bf16(v[i][0], v[i][1]); w.y = cvt_pk_bf16(v[i][2], v[i][3]);
                *(u32x2*)(hout + (size_t)row * 1024 + i * 256 + 4 * lane) = w; }
            if (MODE == 1) {
                float my = 0.f;
#pragma unroll
                for (int g = 0; g < 16; ++g) { float a = 0.f;
#pragma unroll
                    for (int i = 0; i < 4; ++i) { const f32x4 w4 = *(const f32x4*)(WgT + g * 1024 + i * 256 + 4 * lane); a += v[i][0] * w4[0] + v[i][1] * w4[1] + v[i][2] * w4[2] + v[i][3] * w4[3]; }
                    a = wave_sum(a); if (lane == g) my = a; }
                if (lane < 16) gates[(size_t)row * 16 + lane] = my + p.b_in[4096 + lane];
            }
        }
    }
    __syncthreads();
}

struct EpiSwiglu {
    static constexpr bool PERM = true, AFTER_DRAIN = false; bf16_t* O;
    template <int MT> DEVI void operator()(const f32x4 (&acc)[2][2][MT][2], const Unit& u, int wr, int wc, int fr, int fq) const {
        const int row0 = u.pm * 64 * MT + wr * 16 * MT + fr, col0 = u.pn * 128 + wc * 32 + 8 * fq;
#pragma unroll
        for (int ai = 0; ai < 2; ++ai)
#pragma unroll
            for (int m = 0; m < MT; ++m) { bf16_t* rowp = O + (size_t)(row0 + ai * 32 * MT + m * 16) * 2816 + col0;
                float r[8];
#pragma unroll
                for (int n = 0; n < 2; ++n)
#pragma unroll
                    for (int j = 0; j < 4; ++j) r[4 * n + j] = silu(acc[ai][0][m][n][j]) * acc[ai][1][m][n][j];
                u32x4 w; w.x = cvt_pk_bf16(r[0], r[1]); w.y = cvt_pk_bf16(r[2], r[3]); w.z = cvt_pk_bf16(r[4], r[5]); w.w = cvt_pk_bf16(r[6], r[7]);
                *(u32x4*)rowp = w; }
    }
};
struct EpiResid {
    static constexpr bool PERM = false, AFTER_DRAIN = false; const float* xa; const float* xb; float* xo; const float* gate; float scale;
    template <int MT> DEVI void operator()(const f32x4 (&acc)[2][2][MT][2], const Unit& u, int wr, int wc, int fr, int fq) const {
        const int row0 = u.pm * 64 * MT + wr * 16 * MT + fr, col0 = u.pn * 256 + wc * 32 + 4 * fq;
        const int c_lo = cond_of_row(u.pm * 64 * MT), c_hi = cond_of_row(u.pm * 64 * MT + 64 * MT - 1);
        f32x4 g0[2][2], g1[2][2];
#pragma unroll
        for (int bj = 0; bj < 2; ++bj)
#pragma unroll
            for (int n = 0; n < 2; ++n) { g0[bj][n] = scale * *(const f32x4*)(gate + c_lo * 9216 + col0 + bj * 128 + n * 16); g1[bj][n] = scale * *(const f32x4*)(gate + c_hi * 9216 + col0 + bj * 128 + n * 16); }
#pragma unroll
        for (int ai = 0; ai < 2; ++ai) {
            f32x4 xv[MT][2][2];
#pragma unroll
            for (int m = 0; m < MT; ++m) { const int row = row0 + ai * 32 * MT + m * 16;
                const float* xi = (row < NPR) ? xa + (size_t)row * 1024 : xb + (size_t)(row - NPR) * 1024;
#pragma unroll
                for (int bj = 0; bj < 2; ++bj)
#pragma unroll
                    for (int n = 0; n < 2; ++n) xv[m][bj][n] = *(const f32x4*)(xi + col0 + bj * 128 + n * 16); }
#pragma unroll
            for (int m = 0; m < MT; ++m) { const int row = row0 + ai * 32 * MT + m * 16; float* xop = xo + (size_t)row * 1024; const bool hi = cond_of_row(row) != c_lo;
#pragma unroll
                for (int bj = 0; bj < 2; ++bj)
#pragma unroll
                    for (int n = 0; n < 2; ++n) { const f32x4 gv = hi ? g1[bj][n] : g0[bj][n]; *(f32x4*)(xop + col0 + bj * 128 + n * 16) = xv[m][bj][n] + gv * acc[ai][bj][m][n]; } }
        }
    }
};
struct EpiZ {
    static constexpr bool PERM = true, AFTER_DRAIN = false; unsigned char* zbase; const float* binp;
    template <int MT> DEVI void operator()(const f32x4 (&acc)[2][2][MT][2], const Unit& u, int wr, int wc, int fr, int fq) const {
        const int pn = u.pn, row0 = u.pm * 64 * MT + wr * 16 * MT + fr, cl = wc * 32 + 8 * fq;
        f32x4 bv[2][2];
#pragma unroll
        for (int bj = 0; bj < 2; ++bj)
#pragma unroll
            for (int n = 0; n < 2; ++n) bv[bj][n] = *(const f32x4*)(binp + pn * 256 + bj * 128 + cl + 4 * n);
        if (pn >= 20 && pn < 28) {
            bf16_t* O = (bf16_t*)(zbase + 5 * TB) + (pn - 20) * 128 + cl;
#pragma unroll
            for (int ai = 0; ai < 2; ++ai)
#pragma unroll
                for (int m = 0; m < MT; ++m) { float r[8];
#pragma unroll
                    for (int n = 0; n < 2; ++n)
#pragma unroll
                        for (int j = 0; j < 4; ++j) r[4 * n + j] = (acc[ai][0][m][n][j] + bv[0][n][j]) * (acc[ai][1][m][n][j] + bv[1][n][j]);
                    u32x4 w; w.x = cvt_pk_bf16(r[0], r[1]); w.y = cvt_pk_bf16(r[2], r[3]); w.z = cvt_pk_bf16(r[4], r[5]); w.w = cvt_pk_bf16(r[6], r[7]);
                    *(u32x4*)(O + (size_t)(row0 + ai * 32 * MT + m * 16) * 1024) = w; }
        } else {
            const int seg = pn < 20 ? (pn >> 2) : (pn < 32 ? 6 : 7);
            const int cb = pn < 20 ? (pn & 3) * 256 : ((pn - 28) & 3) * 256;
            const bool sg = (seg == 3) || (seg >= 6); const float mul = (seg == 1) ? 0.0625f : 1.f;
            bf16_t* O = (bf16_t*)(zbase + (size_t)seg * TB) + cb + cl;
#pragma unroll
            for (int ai = 0; ai < 2; ++ai)
#pragma unroll
                for (int m = 0; m < MT; ++m)
#pragma unroll
                    for (int bj = 0; bj < 2; ++bj) { float r[8];
#pragma unroll
                        for (int n = 0; n < 2; ++n)
#pragma unroll
                            for (int j = 0; j < 4; ++j) { float x = (acc[ai][bj][m][n][j] + bv[bj][n][j]) * mul; r[4 * n + j] = sg ? sigm(x) : x; }
                        u32x4 w; w.x = cvt_pk_bf16(r[0], r[1]); w.y = cvt_pk_bf16(r[2], r[3]); w.z = cvt_pk_bf16(r[4], r[5]); w.w = cvt_pk_bf16(r[6], r[7]);
                        *(u32x4*)(O + (size_t)(row0 + ai * 32 * MT + m * 16) * 1024 + bj * 128) = w; }
        }
    }
};
template <int SECOND> struct EpiY {
    static constexpr bool PERM = true, AFTER_DRAIN = false; const bf16_t* gate; bf16_t* Y;
    template <int MT> DEVI void operator()(const f32x4 (&acc)[2][2][MT][2], const Unit& u, int wr, int wc, int fr, int fq) const {
        const int row0 = u.pm * 64 * MT + wr * 16 * MT + fr, col0 = u.pn * 256 + wc * 32 + 8 * fq;
#pragma unroll
        for (int ai = 0; ai < 2; ++ai)
        { u32x4 gws[MT][2], yws[MT][2];
#pragma unroll
            for (int m = 0; m < MT; ++m)
#pragma unroll
                for (int bj = 0; bj < 2; ++bj) { const size_t off = (size_t)(row0 + ai * 32 * MT + m * 16) * 1024 + col0 + bj * 128; gws[m][bj] = *(const u32x4*)(gate + off); if (SECOND) yws[m][bj] = *(const u32x4*)(Y + off); }
#pragma unroll
            for (int m = 0; m < MT; ++m)
#pragma unroll
                for (int bj = 0; bj < 2; ++bj) { const size_t off = (size_t)(row0 + ai * 32 * MT + m * 16) * 1024 + col0 + bj * 128;
                    const u32x4 gw = gws[m][bj]; float r[8];
                    r[0] = bf_lo(gw.x) * acc[ai][bj][m][0][0]; r[1] = bf_hi(gw.x) * acc[ai][bj][m][0][1]; r[2] = bf_lo(gw.y) * acc[ai][bj][m][0][2]; r[3] = bf_hi(gw.y) * acc[ai][bj][m][0][3];
                    r[4] = bf_lo(gw.z) * acc[ai][bj][m][1][0]; r[5] = bf_hi(gw.z) * acc[ai][bj][m][1][1]; r[6] = bf_lo(gw.w) * acc[ai][bj][m][1][2]; r[7] = bf_hi(gw.w) * acc[ai][bj][m][1][3];
                    if (SECOND) { const u32x4 yw = yws[m][bj];
                        r[0] += bf_lo(yw.x); r[1] += bf_hi(yw.x); r[2] += bf_lo(yw.y); r[3] += bf_hi(yw.y); r[4] += bf_lo(yw.z); r[5] += bf_hi(yw.z); r[6] += bf_lo(yw.w); r[7] += bf_hi(yw.w); }
                    u32x4 w; w.x = cvt_pk_bf16(r[0], r[1]); w.y = cvt_pk_bf16(r[2], r[3]); w.z = cvt_pk_bf16(r[4], r[5]); w.w = cvt_pk_bf16(r[6], r[7]);
                    *(u32x4*)(Y + off) = w; } }
    }
};
template <int MT, class Epi> DEVI void run_gemm(const bf16_t* A, const bf16_t* Bt, int N, int K, const Epi& E, unsigned char* shm) {
    pg8::Gemm g; g.A = A; g.Bt = Bt; g.M = NTOK; g.N = N; g.K = K;
    pg8::StaticOrder S; S.init(NTOK, N, (int)gridDim.x, (int)blockIdx.x, 64 * MT);
    pg8::gemm_phase<Epi, pg8::StaticOrder, false, MT>((PG8_LAS unsigned char*)shm, g, S, E, nullptr);
    __syncthreads();
}

namespace ml {
constexpr int S_OFF = 0, A_OFF = 67584, B_OFF = 86016, T_BYTES = 33792, V_OFF = 153600;
template <int NP> DEVI void ld_nat(int tid, u32x4 (&r)[NP], const bf16_t* src, int ld) {
#pragma unroll
    for (int i = 0; i < NP; ++i) { const int idx = tid + 512 * i, row = idx >> 3, cp = idx & 7; r[i] = *(const u32x4*)(src + (size_t)row * ld + cp * 8); }
}
template <int NP> DEVI void st_nat(int tid, const u32x4 (&r)[NP], unsigned char* dst) {
#pragma unroll
    for (int i = 0; i < NP; ++i) { const int idx = tid + 512 * i, row = idx >> 3, cp = idx & 7; *(u32x4*)(dst + row * 144 + cp * 16) = r[i]; }
}
template <int NP> DEVI void ld_tr(int tid, u32x4 (&r)[NP], const bf16_t* src, int ld) {
    constexpr int PPR = NP * 8;
#pragma unroll
    for (int i = 0; i < NP; ++i) { const int idx = tid + 512 * i, kr = idx / PPR, cp = idx % PPR; r[i] = *(const u32x4*)(src + (size_t)kr * ld + cp * 8); }
}
template <int NP> DEVI void st_tr(int tid, const u32x4 (&r)[NP], unsigned char* T) {
    constexpr int PPR = NP * 8;
#pragma unroll
    for (int i = 0; i < NP; ++i) { const int idx = tid + 512 * i, kr = idx / PPR, cp = idx % PPR; *(u32x4*)(T + kr * 528 + cp * 16) = r[i]; }
}
typedef short v4i16 __attribute__((ext_vector_type(4)));
DEVI bf16x8 tr_frag(const unsigned char* T, int k0, int n0, int lane) {
    const int i = lane & 15, g = lane >> 4;
    const LAS v4i16* p = (const LAS v4i16*)(T + (k0 + 8 * g + (i >> 2)) * 528 + (n0 + 4 * (i & 3)) * 2);
    const v4i16 lo = __builtin_amdgcn_ds_read_tr16_b64_v4i16((LAS v4i16*)p), hi = __builtin_amdgcn_ds_read_tr16_b64_v4i16((LAS v4i16*)(p + 264));
    bf16x8 r; r[0] = lo[0]; r[1] = lo[1]; r[2] = lo[2]; r[3] = lo[3]; r[4] = hi[0]; r[5] = hi[1]; r[6] = hi[2]; r[7] = hi[3]; return r;
}
template <bool AT, bool BT> DEVI void mma_slab(f32x4 (&acc)[4][4], const unsigned char* Ab, int astride, const unsigned char* Bb, int wr, int wc, int lane) {
    const int fr = lane & 15, fq = lane >> 4;
#pragma unroll
    for (int ks = 0; ks < 2; ++ks) { bf16x8 a[4], b[4];
#pragma unroll
        for (int m = 0; m < 4; ++m) a[m] = AT ? tr_frag(Ab, 32 * ks, 64 * wr + 16 * m, lane) : *(const bf16x8*)(Ab + (64 * wr + 16 * m + fr) * astride + (32 * ks + 8 * fq) * 2);
#pragma unroll
        for (int n = 0; n < 4; ++n) b[n] = BT ? tr_frag(Bb, 32 * ks, 64 * wc + 16 * n, lane) : *(const bf16x8*)(Bb + (64 * wc + 16 * n + fr) * 144 + (32 * ks + 8 * fq) * 2);
#pragma unroll
        for (int m = 0; m < 4; ++m)
#pragma unroll
            for (int n = 0; n < 4; ++n) acc[m][n] = __builtin_amdgcn_mfma_f32_16x16x32_bf16(b[n], a[m], acc[m][n], 0, 0, 0); }
}
template <int AM, int BM, int DP> DEVI void bgemm(f32x4 (&acc)[4][4], unsigned char* shm, const bf16_t* Asrc, int lda, const bf16_t* Bsrc, int ldb, int nslab, int a_koff, const float* ascale) {
    u32x4 ra[DP][2], rb[DP][4];
    int t = threadIdx.x; asm volatile("" : "+v"(t));
    const int wid = t >> 6, lane = t & 63, wr = wid >> 2, wc = wid & 3;
    constexpr bool AG = (AM == 0 || AM == 3);
#define BG_LOAD(d, i) do { if (AG) ld_nat<2>(t, ra[d], Asrc + (i) * 64, lda); \
        if (BM == 0) ld_nat<4>(t, rb[d], Bsrc + (i) * 64, ldb); else ld_tr<4>(t, rb[d], Bsrc + (size_t)(i) * 64 * ldb, ldb); } while (0)
#pragma unroll
    for (int d = 0; d < DP; ++d) if (d < nslab) BG_LOAD(d, d);
#pragma unroll 1
    for (int i0 = 0; i0 < nslab; i0 += DP) {
#pragma unroll
        for (int d = 0; d < DP; ++d) { const int i = i0 + d;
            if (i < nslab) {
                unsigned char* Bb = shm + B_OFF + ((BM == 1) ? (i & 1) * T_BYTES : 0);
                if (AM == 0) st_nat<2>(t, ra[d], shm + A_OFF);
                if (AM == 3) {
#pragma unroll
                    for (int q = 0; q < 2; ++q) { const int idx = t + 512 * q, row = idx >> 3, cp = idx & 7; const float w = ascale[row]; const u32x4 x = ra[d][q]; u32x4 y;
                        y.x = cvt_pk_bf16(bf_lo(x.x) * w, bf_hi(x.x) * w); y.y = cvt_pk_bf16(bf_lo(x.y) * w, bf_hi(x.y) * w); y.z = cvt_pk_bf16(bf_lo(x.z) * w, bf_hi(x.z) * w); y.w = cvt_pk_bf16(bf_lo(x.w) * w, bf_hi(x.w) * w);
                        *(u32x4*)(shm + A_OFF + row * 144 + cp * 16) = y; } }
                if (BM == 0) st_nat<4>(t, rb[d], Bb); else st_tr<4>(t, rb[d], Bb);
                LBAR();
                if (i + DP < nslab) BG_LOAD(d, i + DP);
                mma_slab<false, BM == 1>(acc, (AM == 2) ? (shm + S_OFF + (a_koff + i * 64) * 2) : (shm + A_OFF), (AM == 2) ? 528 : 144, Bb, wr, wc, lane);
                if (AG || BM == 0) LBAR();
            } }
    }
#undef BG_LOAD
    if (AM == 2 && BM == 1) __syncthreads();
}
DEVI void zero_acc(f32x4 (&a)[4][4]) {
#pragma unroll
    for (int m = 0; m < 4; ++m)
#pragma unroll
        for (int n = 0; n < 4; ++n) a[m][n] = (f32x4){0.f, 0.f, 0.f, 0.f};
}
constexpr int TBL_OFF = 159744;
DEVI void chain_table(const Params& p, unsigned char* shm) {
    float* tbl = (float*)(shm + TBL_OFF); const int t = threadIdx.x;
    if (t < 16) { const int b = t >> 3, dh = t & 7, dir = dh >> 2, base = dh * 48 + 16 + b * 16;
        const float* bl = (const float*)(p.ws + OFF_BL) + base; const float* ml = (const float*)(p.ws + OFF_MLOC) + base;
        float blv[16], mlv[16];
#pragma unroll
        for (int s = 0; s < 16; ++s) { const int c = dir ? 15 - s : s; blv[s] = bl[c]; mlv[s] = ml[c]; }
        float m = p.state_m[b * 8 + dh];
#pragma unroll
        for (int s = 0; s < 16; ++s) { const int c = dir ? 15 - s : s; tbl[t * 16 + c] = m; m = fmaxf(blv[s] + m, mlv[s]); } }
    __syncthreads();
}
DEVI void chain_m(const Params& p, const unsigned char* shm, int cgk, int dh, float& m_in, float& m_out) {
    const float* tbl = (const float*)(shm + TBL_OFF);
    float m = 0.f;
    if (cgk >= 16) { const int lc = cgk - 16; m = tbl[((lc >> 4) * 8 + dh) * 16 + (lc & 15)]; }
    m_in = m; m_out = fmaxf(((const float*)(p.ws + OFF_BL))[dh * 48 + cgk] + m, ((const float*)(p.ws + OFF_MLOC))[dh * 48 + cgk]);
}
DEVI void m1_pair(const Params& p, int pair, unsigned char* shm) {
    float* sm = (float*)shm; const int t = threadIdx.x, lane = t & 63, wid = t >> 6, pos = t & 255, item = pair * 2 + (t >> 8);
    const int cgk = item >> 3, dh = item & 7, dir = dh >> 2, w4 = wid & 3, wb = wid & 4;
    const float* gates = (const float*)(p.ws + OFF_GATES);
    const int tok = cgk * 256 + (dir ? 255 - pos : pos);
    const float ii = gates[(size_t)tok * 16 + dh], f = gates[(size_t)tok * 16 + 8 + dh];
    float v = fminf(f, 0.f) - log1pf(expf(-fabsf(f)));
#pragma unroll
    for (int off = 1; off < 64; off <<= 1) { const float o = __shfl_up(v, off); if (lane >= off) v += o; }
    if (lane == 63) sm[wid] = v;
    __syncthreads();
    for (int k = 0; k < w4; ++k) v += sm[wb + k];
    const float b = v, gi = ii - b; float mx = gi;
#pragma unroll
    for (int off = 1; off < 64; off <<= 1) { const float o = __shfl_up(mx, off); if (lane >= off) mx = fmaxf(mx, o); }
    if (lane == 63) sm[8 + wid] = mx;
    __syncthreads();
    for (int k = 0; k < w4; ++k) mx = fmaxf(mx, sm[8 + wb + k]);
    ((float*)(p.ws + OFF_BQ))[dh * NTOK + tok] = b; ((float*)(p.ws + OFF_GI))[dh * NTOK + tok] = gi; ((float*)(p.ws + OFF_PMX))[dh * NTOK + tok] = mx;
    if (pos == 255) { ((float*)(p.ws + OFF_BL))[dh * 48 + cgk] = b; ((float*)(p.ws + OFF_MLOC))[dh * 48 + cgk] = b + mx; }
    __syncthreads();
}
DEVI void m2_item(const Params& p, int item, unsigned char* shm) {
    int t = threadIdx.x; asm volatile("" : "+v"(t));
    const int wid = t >> 6, lane = t & 63, wr = wid >> 2, wc = wid & 3, fr = lane & 15, fq = lane >> 4;
    const int cgk = item >> 4, dh = (item >> 1) & 7, half = item & 1, head = dh & 3, r0 = cgk * 256;
    float m_in, m_out; chain_m(p, shm, cgk, dh, m_in, m_out);
    float* vwk = (float*)(shm + V_OFF);
    const float blv = ((const float*)(p.ws + OFF_BL))[dh * 48 + cgk];
    if (t < 256) vwk[t] = __expf(blv + ((const float*)(p.ws + OFF_GI))[dh * NTOK + r0 + t] - m_out);
    __syncthreads();
    const bf16_t* kb = zbuf(p, 1) + (size_t)r0 * 1024 + head * 256 + 128 * half; const bf16_t* vb = zbuf(p, 2) + (size_t)r0 * 1024 + head * 256;
    f32x4 acc[4][4]; zero_acc(acc);
    float dn = 0.f;
    u32x4 ra[2], rb[4];
    ld_tr<2>(t, ra, kb, 1024); ld_tr<4>(t, rb, vb, 1024);
#pragma unroll 1
    for (int i = 0; i < 4; ++i) {
        unsigned char* Ta = shm + S_OFF + (i & 1) * T_BYTES; unsigned char* Tb = shm + B_OFF + (i & 1) * T_BYTES;
#pragma unroll
        for (int q = 0; q < 2; ++q) { const int idx = t + 512 * q, kr = idx >> 4, cp = idx & 15; const float w = vwk[i * 64 + kr]; u32x4 x = ra[q], y;
            y.x = cvt_pk_bf16(bf_lo(x.x) * w, bf_hi(x.x) * w); y.y = cvt_pk_bf16(bf_lo(x.y) * w, bf_hi(x.y) * w); y.z = cvt_pk_bf16(bf_lo(x.z) * w, bf_hi(x.z) * w); y.w = cvt_pk_bf16(bf_lo(x.w) * w, bf_hi(x.w) * w);
            *(u32x4*)(Ta + kr * 528 + cp * 16) = y; }
        st_tr<4>(t, rb, Tb);
        LBAR();
        if (i + 1 < 4) { ld_tr<2>(t, ra, kb + (size_t)(i + 1) * 64 * 1024, 1024); ld_tr<4>(t, rb, vb + (size_t)(i + 1) * 64 * 1024, 1024); }
        {
            unsigned short dv_[16];
#pragma unroll
            for (int j = 0; j < 16; ++j) dv_[j] = *(const unsigned short*)(Ta + ((t >> 7) * 16 + j) * 528 + 2 * (t & 127));
#pragma unroll
            for (int j = 0; j < 16; ++j) dn += bf2f(dv_[j]); }
        mma_slab<true, true>(acc, Ta, 0, Tb, wr, wc, lane);
    }
    { float* dred = vwk + 256; dred[t] = dn; __syncthreads();
      if (t < 128) { dn = dred[t] + dred[t + 128] + dred[t + 256] + dred[t + 384];
        if (cgk < 16) p.out[(size_t)NTOK * 1024 + (size_t)16 * 8 * 65536 + (cgk * 8 + dh) * 256 + 128 * half + t] = dn;
        else ((float*)(p.ws + OFF_DN))[(dh * 48 + cgk) * 256 + 128 * half + t] = dn; } }
    if (cgk < 16) {
        float* C = p.out + (size_t)NTOK * 1024 + (size_t)(cgk * 8 + dh) * 65536;
#pragma unroll
        for (int m = 0; m < 4; ++m)
#pragma unroll
            for (int n = 0; n < 4; ++n) *(f32x4*)(C + (128 * half + 64 * wr + 16 * m + fr) * 256 + 64 * wc + 16 * n + 4 * fq) = acc[m][n];
        if (half == 0 && t == 0) p.out[(size_t)NTOK * 1024 + (size_t)16 * 8 * 65536 + 16 * 8 * 256 + cgk * 8 + dh] = m_out;
    } else {
        bf16_t* C = (bf16_t*)(p.ws + OFF_CIN) + (size_t)(dh * 32 + (cgk - 16)) * 65536;
#pragma unroll
        for (int m = 0; m < 4; ++m)
#pragma unroll
            for (int n = 0; n < 4; ++n) { u32x2 w; w.x = cvt_pk_bf16(acc[m][n][0], acc[m][n][1]); w.y = cvt_pk_bf16(acc[m][n][2], acc[m][n][3]);
                *(u32x2*)(C + (128 * half + 64 * wr + 16 * m + fr) * 256 + 64 * wc + 16 * n + 4 * fq) = w; }
    }
    __syncthreads();
}
DEVI void m3_phase(const Params& p) {
    const int t = threadIdx.x;
    for (int it = blockIdx.x; it < 256; it += gridDim.x) {
        const int chain = it >> 4, seg = it & 15, b = chain >> 3, dh = chain & 7, dir = dh >> 2;
        const size_t e0 = (size_t)seg * 4096 + t * 8;
        const float* bl = (const float*)(p.ws + OFF_BL) + dh * 48 + 16 + b * 16; const float* mlc = (const float*)(p.ws + OFF_MLOC) + dh * 48 + 16 + b * 16;
        bf16_t* base = (bf16_t*)(p.ws + OFF_CIN) + (size_t)(dh * 32 + b * 16) * 65536 + e0;
        float* nbase = (float*)(p.ws + OFF_DN) + (dh * 48 + 16 + b * 16) * 256 + t;
        const bool do_n = (seg == 0 && t < 256);
        u32x4 dv[16]; float dnv[16];
#pragma unroll
        for (int c = 0; c < 16; ++c) { dv[c] = *(const u32x4*)(base + (size_t)c * 65536); dnv[c] = do_n ? nbase[c * 256] : 0.f; }
        float st[8]; { const f32x4 a = *(const f32x4*)(p.state_C + (size_t)(b * 8 + dh) * 65536 + e0), c = *(const f32x4*)(p.state_C + (size_t)(b * 8 + dh) * 65536 + e0 + 4);
            st[0] = a[0]; st[1] = a[1]; st[2] = a[2]; st[3] = a[3]; st[4] = c[0]; st[5] = c[1]; st[6] = c[2]; st[7] = c[3]; }
        float sn = do_n ? p.state_n[(b * 8 + dh) * 256 + t] : 0.f;
        float m = p.state_m[b * 8 + dh];
#pragma unroll
        for (int step = 0; step < 16; ++step) {
            const int cf = step, cb = 15 - step;
            const float blv = dir ? bl[cb] : bl[cf], mlv = dir ? mlc[cb] : mlc[cf];
            const float m_new = fmaxf(blv + m, mlv), decay = __expf(blv + m - m_new);
            const u32x4 d4 = dir ? dv[cb] : dv[cf]; const float dn1 = dir ? dnv[cb] : dnv[cf];
            u32x4 w; w.x = cvt_pk_bf16(st[0], st[1]); w.y = cvt_pk_bf16(st[2], st[3]); w.z = cvt_pk_bf16(st[4], st[5]); w.w = cvt_pk_bf16(st[6], st[7]);
            *(u32x4*)(base + (size_t)(dir ? cb : cf) * 65536) = w;
            st[0] = decay * st[0] + bf_lo(d4.x); st[1] = decay * st[1] + bf_hi(d4.x); st[2] = decay * st[2] + bf_lo(d4.y); st[3] = decay * st[3] + bf_hi(d4.y);
            st[4] = decay * st[4] + bf_lo(d4.z); st[5] = decay * st[5] + bf_hi(d4.z); st[6] = decay * st[6] + bf_lo(d4.w); st[7] = decay * st[7] + bf_hi(d4.w);
            if (do_n) { nbase[(dir ? cb : cf) * 256] = sn; sn = decay * sn + dn1; }
            m = m_new;
        }
    }
}
DEVI void conv_phase(const Params& p) {
    const bf16_t* u = zbuf(p, 5); bf16_t* bg = zbuf(p, 4);
    const int c8 = (threadIdx.x & 127) * 8, rsub = threadIdx.x >> 7;
    float w0[8], w1[8], w2[8], cb[8];
#pragma unroll
    for (int q = 0; q < 2; ++q) { const f32x4 a = *(const f32x4*)(p.conv_w + c8 + 4 * q), b = *(const f32x4*)(p.conv_w + 1024 + c8 + 4 * q), c = *(const f32x4*)(p.conv_w + 2048 + c8 + 4 * q), d = *(const f32x4*)(p.conv_b + c8 + 4 * q);
#pragma unroll
        for (int j = 0; j < 4; ++j) { w0[4 * q + j] = a[j]; w1[4 * q + j] = b[j]; w2[4 * q + j] = c[j]; cb[4 * q + j] = d[j]; } }
    for (int row = blockIdx.x * 4 + rsub; row < NTOK; row += gridDim.x * 4) {
        const int per = row < NPR ? 256 : 64, pos = row & (per - 1);
        const size_t o = (size_t)row * 1024 + c8;
        const u32x4 z4 = {0u, 0u, 0u, 0u};
        const u32x4 uc = *(const u32x4*)(u + o), um = pos > 0 ? *(const u32x4*)(u + o - 1024) : z4, up = pos < per - 1 ? *(const u32x4*)(u + o + 1024) : z4, bv = *(const u32x4*)(bg + o);
        float r[8];
#pragma unroll
        for (int q = 0; q < 4; ++q) {
            r[2 * q] = bf_lo(bv[q]) * (w0[2 * q] * bf_lo(um[q]) + w1[2 * q] * bf_lo(uc[q]) + w2[2 * q] * bf_lo(up[q]) + cb[2 * q]);
            r[2 * q + 1] = bf_hi(bv[q]) * (w0[2 * q + 1] * bf_hi(um[q]) + w1[2 * q + 1] * bf_hi(uc[q]) + w2[2 * q + 1] * bf_hi(up[q]) + cb[2 * q + 1]); }
        u32x4 w; w.x = cvt_pk_bf16(r[0], r[1]); w.y = cvt_pk_bf16(r[2], r[3]); w.z = cvt_pk_bf16(r[4], r[5]); w.w = cvt_pk_bf16(r[6], r[7]);
        *(u32x4*)(bg + o) = w;
    }
}
DEVI void out_item(const Params& p, int item, unsigned char* shm) {
    const int cgk = item >> 3, head = (item >> 1) & 3, half = item & 1, r0 = cgk * 256, t0 = r0 + 128 * half;
    const bool latent = cgk >= 16;
    const bf16_t* qb = zbuf(p, 0) + (size_t)t0 * 1024 + head * 256; bf16_t* omb = zbuf(p, 0) + (size_t)t0 * 1024 + head * 256;     const bf16_t* kb = zbuf(p, 1) + (size_t)r0 * 1024 + head * 256;
    const bf16_t* vb = zbuf(p, 2) + (size_t)r0 * 1024 + head * 256; const bf16_t* ob = zbuf(p, 3) + (size_t)t0 * 1024 + head * 256;
    float* vgi = (float*)(shm + V_OFF); float* vmx = vgi + 256; float* vwi = vmx + 128; float* vsc = vwi + 128; float* vmt = vsc + 128; float* vqn = vmt + 128; float* red = vqn + 128;
    f32x4 h[4][4]; zero_acc(h);
#pragma unroll 1
    for (int dir = 0; dir < 2; ++dir) {
        int t = threadIdx.x; asm volatile("" : "+v"(t));
        const int wid = t >> 6, lane = t & 63, wr = wid >> 2, wc = wid & 3, fr = lane & 15, fq = lane >> 4;
        const int dh = dir * 4 + head;
        float m_in, m_out; chain_m(p, shm, cgk, dh, m_in, m_out);
        if (t < 256) vgi[t] = ((const float*)(p.ws + OFF_GI))[dh * NTOK + r0 + t];
        if (t < 128) { const float pm = ((const float*)(p.ws + OFF_PMX))[dh * NTOK + t0 + t], mx = fmaxf(m_in, pm);
            vmx[t] = mx; vwi[t] = __expf(m_in - mx); vmt[t] = ((const float*)(p.ws + OFF_BQ))[dh * NTOK + t0 + t] + mx; }
        {
            const int row = t >> 2, part = t & 3; float qn = 0.f;
            if (latent) { const float* nin = (const float*)(p.ws + OFF_DN) + (dh * 48 + cgk) * 256 + 64 * part;
#pragma unroll
                for (int i = 0; i < 8; ++i) { const u32x4 w = *(const u32x4*)(qb + (size_t)row * 1024 + 64 * part + 8 * i); const f32x4 n0 = *(const f32x4*)(nin + 8 * i), n1 = *(const f32x4*)(nin + 8 * i + 4);
                    qn += bf_lo(w.x) * n0[0] + bf_hi(w.x) * n0[1] + bf_lo(w.y) * n0[2] + bf_hi(w.y) * n0[3] + bf_lo(w.z) * n1[0] + bf_hi(w.z) * n1[1] + bf_lo(w.w) * n1[2] + bf_hi(w.w) * n1[3]; } }
            qn += __shfl_xor(qn, 1); qn += __shfl_xor(qn, 2);
            if (part == 0) vqn[row] = qn;
        }
        __syncthreads();
        {
            f32x4 acc[4][4]; zero_acc(acc);
            bgemm<0, 0, 1>(acc, shm, qb, 1024, kb, 1024, 4, 0, nullptr);
#pragma unroll
            for (int m = 0; m < 4; ++m) { const int tl = 64 * wr + 16 * m + fr, tt = 128 * half + tl; const float mx = vmx[tl]; float rs = 0.f;
#pragma unroll
                for (int n = 0; n < 4; ++n) { const int s0 = 64 * wc + 16 * n + 4 * fq;
#pragma unroll
                    for (int j = 0; j < 4; ++j) { const int s = s0 + j; const bool valid = dir == 0 ? (s <= tt) : (s >= tt); const float w = valid ? acc[m][n][j] * __expf(vgi[s] - mx) : 0.f; acc[m][n][j] = w; rs += w; } }
                rs += __shfl_xor(rs, 16); rs += __shfl_xor(rs, 32);
                if (fq == 0) red[tl * 4 + wc] = rs; }
            __syncthreads();
#pragma unroll
            for (int m = 0; m < 4; ++m) { const int tl = 64 * wr + 16 * m + fr; const f32x4 rr = *(const f32x4*)(red + tl * 4); const float wi = vwi[tl];
                const float den = rr[0] + rr[1] + rr[2] + rr[3] + wi * vqn[tl], rd = 1.f / fmaxf(fabsf(den), __expf(-vmt[tl]));
                if (wc == 0 && fq == 0) vsc[tl] = wi * rd;
#pragma unroll
                for (int n = 0; n < 4; ++n) { const int s0 = 64 * wc + 16 * n + 4 * fq;
                    u32x2 w; w.x = cvt_pk_bf16(acc[m][n][0] * rd, acc[m][n][1] * rd); w.y = cvt_pk_bf16(acc[m][n][2] * rd, acc[m][n][3] * rd); *(u32x2*)(shm + S_OFF + tl * 528 + s0 * 2) = w; } }
        }
        __syncthreads();
        if (latent) bgemm<3, 1, 2>(h, shm, qb, 1024, (const bf16_t*)(p.ws + OFF_CIN) + (size_t)(dh * 32 + (cgk - 16)) * 65536, 256, 4, 0, vsc);
        const int s_lo = dir == 0 ? 0 : 2 * half, s_hi = dir == 0 ? 2 * (half + 1) : 4;
        bgemm<2, 1, 2>(h, shm, nullptr, 0, vb + (size_t)(64 * s_lo) * 1024, 1024, s_hi - s_lo, 64 * s_lo, nullptr);
    }
    int t = threadIdx.x; asm volatile("" : "+v"(t));
    const int wid = t >> 6, lane = t & 63, wr = wid >> 2, wc = wid & 3, fr = lane & 15, fq = lane >> 4;
    float ss[4];
#pragma unroll
    for (int m = 0; m < 4; ++m) { float a = 0.f;
#pragma unroll
        for (int n = 0; n < 4; ++n) a += h[m][n][0] * h[m][n][0] + h[m][n][1] * h[m][n][1] + h[m][n][2] * h[m][n][2] + h[m][n][3] * h[m][n][3];
        a += __shfl_xor(a, 16); a += __shfl_xor(a, 32); ss[m] = a; }
    if (fq == 0) {
#pragma unroll
        for (int m = 0; m < 4; ++m) red[(64 * wr + 16 * m + fr) * 4 + wc] = ss[m]; }
    __syncthreads();
    f32x4 mnv[4]; u32x2 owv[4][4];
#pragma unroll
    for (int n = 0; n < 4; ++n) mnv[n] = *(const f32x4*)(p.ml_norm + head * 256 + 64 * wc + 16 * n + 4 * fq);
#pragma unroll
    for (int m = 0; m < 4; ++m)
#pragma unroll
        for (int n = 0; n < 4; ++n) owv[m][n] = *(const u32x2*)(ob + (size_t)(64 * wr + 16 * m + fr) * 1024 + 64 * wc + 16 * n + 4 * fq);
#pragma unroll
    for (int m = 0; m < 4; ++m) { const int tl = 64 * wr + 16 * m + fr; const f32x4 rr = *(const f32x4*)(red + tl * 4);
        const float rstd = rsqrtf((rr[0] + rr[1] + rr[2] + rr[3]) * (1.f / 256.f) + 1e-6f);
#pragma unroll
        for (int n = 0; n < 4; ++n) { const int col = 64 * wc + 16 * n + 4 * fq; const f32x4 mn = mnv[n];
            const u32x2 ow = owv[m][n];
            u32x2 w; w.x = cvt_pk_bf16(h[m][n][0] * rstd * mn[0] * bf_lo(ow.x), h[m][n][1] * rstd * mn[1] * bf_hi(ow.x));
            w.y = cvt_pk_bf16(h[m][n][2] * rstd * mn[2] * bf_lo(ow.y), h[m][n][3] * rstd * mn[3] * bf_hi(ow.y));
            *(u32x2*)(omb + (size_t)tl * 1024 + col) = w; } }
    __syncthreads();
}
}

__global__ __launch_bounds__(512, 2) void mega(Params p) {
    extern __shared__ __attribute__((aligned(16))) unsigned char shm[];
    cg::grid_group grid = cg::this_grid();
    const int lo = p.phase_lo, hi = p.phase_hi, rm_ = p.rep_mask;
#ifndef REP_MASK
#define REP_MASK 0
#endif
#ifdef ONLY
#define PH(k) if ((k) == ONLY)
#else
#define PH(k) if (lo <= (k) && (k) < hi)
#endif
#define SYNC(k) if (lo <= (k) && (k) + 1 < hi) xcd_barrier(xbar)
    if (threadIdx.x < 4) ((LAS unsigned*)((LAS unsigned char*)shm + ST_OFF))[threadIdx.x] = 0u;
    __syncthreads();
    XcdBarrier xbar; xbar.bar = (unsigned*)(p.ws + OFF_BAR); xbar.x = 0; xbar.st = nullptr;
    if (hi > 100) grid.sync();
    if (hi - lo > 1) xbar = xcd_barrier_post((unsigned*)(p.ws + OFF_BAR), (volatile LAS unsigned*)((LAS unsigned char*)shm + ST_OFF));
    float* mod = (float*)(p.ws + OFF_MOD);
    bf16_t* hbuf = (bf16_t*)(p.out + (size_t)NTOK * 1024);
    bf16_t* act = (bf16_t*)(p.ws + OFF_Z);
    PH(0) { phase0(p, shm); }
    if (((REP_MASK >> 0) & 1) && ((rm_ >> 0) & 1)) PH(0) { phase0(p, shm); }
    SYNC(0);
    PH(1) { row_phase<0>(p, shm); }
    if (((REP_MASK >> 1) & 1) && ((rm_ >> 1) & 1)) PH(1) { row_phase<0>(p, shm); }
    SYNC(1);
    PH(2) { { EpiSwiglu E; E.O = act; run_gemm<4>(hbuf, (const bf16_t*)(p.ws + OFF_W1T), 5632, 1024, E, shm); if (gridDim.x > 64) { if (blockIdx.x >= 32) conv_items(p, shm, 0, 352 + (int)blockIdx.x - 32, 1296, (int)gridDim.x - 32); } else conv_items(p, shm, 0, 352 + (int)blockIdx.x, 1296, (int)gridDim.x);
        if (gridDim.x == 256 && blockIdx.x >= 80 && blockIdx.x < 224) conv_items(p, shm, 1, 384 + (int)blockIdx.x - 80, 528, 1 << 20);     } }
    if (((REP_MASK >> 2) & 1) && ((rm_ >> 2) & 1)) PH(2) { { EpiSwiglu E; E.O = act; run_gemm<4>(hbuf, (const bf16_t*)(p.ws + OFF_W1T), 5632, 1024, E, shm); if (gridDim.x > 64) { if (blockIdx.x >= 32) conv_items(p, shm, 0, 352 + (int)blockIdx.x - 32, 1296, (int)gridDim.x - 32); } else conv_items(p, shm, 0, 352 + (int)blockIdx.x, 1296, (int)gridDim.x); } }
    SYNC(2);
    PH(3) { { EpiResid E; E.xa = p.x_prompt; E.xb = p.x_sample; E.xo = p.out; E.gate = mod + 2 * 1024; E.scale = 0.5f; run_gemm<GMT>(act, (const bf16_t*)(p.ws + OFF_W2T), 1024, 2816, E, shm); } }
    if (((REP_MASK >> 3) & 1) && ((rm_ >> 3) & 1)) PH(3) { { EpiResid E; E.xa = p.x_prompt; E.xb = p.x_sample; E.xo = p.out; E.gate = mod + 2 * 1024; E.scale = 0.5f; run_gemm<GMT>(act, (const bf16_t*)(p.ws + OFF_W2T), 1024, 2816, E, shm); } }
    SYNC(3);
    PH(4) { row_phase<1>(p, shm); }
    if (((REP_MASK >> 4) & 1) && ((rm_ >> 4) & 1)) PH(4) { row_phase<1>(p, shm); }
    SYNC(4);
    PH(5) { {
        if (gridDim.x == 256) { if (blockIdx.x >= 192) for (int it = (int)blockIdx.x - 192; it < 192; it += 64) ml::m1_pair(p, it, shm); }
        else for (int it = blockIdx.x; it < 192; it += gridDim.x) ml::m1_pair(p, it, shm);
        __syncthreads();
        EpiZ E; E.zbase = p.ws + OFF_Z; E.binp = (const float*)(p.ws + OFF_BINP); run_gemm<4>(hbuf, (const bf16_t*)(p.ws + OFF_WIN), 9216, 1024, E, shm);
        if (gridDim.x == 256 && blockIdx.x >= 192) conv_items(p, shm, 1, (int)blockIdx.x - 192, 256, 64);
    } }
    if (((REP_MASK >> 5) & 1) && ((rm_ >> 5) & 1)) PH(5) { {
        if (gridDim.x == 256) { if (blockIdx.x >= 192) for (int it = (int)blockIdx.x - 192; it < 192; it += 64) ml::m1_pair(p, it, shm); }
        else for (int it = blockIdx.x; it < 192; it += gridDim.x) ml::m1_pair(p, it, shm);
        __syncthreads();
        EpiZ E; E.zbase = p.ws + OFF_Z; E.binp = (const float*)(p.ws + OFF_BINP); run_gemm<4>(hbuf, (const bf16_t*)(p.ws + OFF_WIN), 9216, 1024, E, shm);
    } }
    SYNC(5);
    PH(6) { { ml::chain_table(p, shm);
        if (gridDim.x == 256) { const int b = blockIdx.x;
            if (b >= 128) { const int c = b - 128; ml::out_item(p, 2 * ((c & 7) * 8 + (c >> 4)) + ((c >> 3) & 1), shm); ml::m2_item(p, 640 + c, shm); conv_items(p, shm, 1, 256 + c, 384, 1 << 20); }
            else { for (int k = 0; k < 5; ++k) ml::m2_item(p, b + 128 * k, shm); } }
        else for (int it = blockIdx.x; it < 768; it += gridDim.x) ml::m2_item(p, it, shm); ml::conv_phase(p); } }
    if (((REP_MASK >> 6) & 1) && ((rm_ >> 6) & 1)) PH(6) { { ml::chain_table(p, shm);
        if (gridDim.x == 256) { const int b = blockIdx.x;
            for (int r = 0; r < 3; ++r) { const int group = r * 64 + (b & 7) * 8 + (b >> 5), member = (b >> 3) & 3, cgk = group >> 2, head = group & 3, dh = (member >> 1) * 4 + head; ml::m2_item(p, cgk * 16 + dh * 2 + (member & 1), shm); } }
        else for (int it = blockIdx.x; it < 768; it += gridDim.x) ml::m2_item(p, it, shm);  } }
    SYNC(6);
    PH(7) { ml::m3_phase(p); }
    if (((REP_MASK >> 7) & 1) && ((rm_ >> 7) & 1)) PH(7) { ml::m3_phase(p); }
    SYNC(7);
    PH(8) { { ml::chain_table(p, shm);
        if (gridDim.x == 256) { const int b = blockIdx.x;
            ml::out_item(p, 128 + 2 * ((b & 7) * 16 + (b >> 4)) + ((b >> 3) & 1), shm); }
        else for (int it = (int)gridDim.x - 1 - (int)blockIdx.x + 0; it < 384; it += gridDim.x) ml::out_item(p, 383 - it, shm);
        if (gridDim.x != 256) conv_items(p, shm, 1, (int)blockIdx.x, 528, (int)gridDim.x); } }
    if (((REP_MASK >> 8) & 1) && ((rm_ >> 8) & 1)) PH(8) { { ml::chain_table(p, shm);
        if (gridDim.x == 256) { const int b = blockIdx.x;
            ml::out_item(p, 128 + 2 * ((b & 7) * 16 + (b >> 4)) + ((b >> 3) & 1), shm);
            if (b >= 128) { const int c = b - 128; ml::out_item(p, 2 * ((c & 7) * 8 + (c >> 4)) + ((c >> 3) & 1), shm); } }
        else for (int it = (int)gridDim.x - 1 - (int)blockIdx.x + 0; it < 384; it += gridDim.x) ml::out_item(p, 383 - it, shm);
        if (gridDim.x == 256) { if (blockIdx.x < 128) conv_items(p, shm, 1, (int)blockIdx.x, 528, 128); }
        else conv_items(p, shm, 1, (int)blockIdx.x, 528, (int)gridDim.x); } }
    SYNC(8);
    PH(9) { {
        { EpiY<0> E; E.gate = zbuf(p, 6); E.Y = zbuf(p, 1); run_gemm<GMT>(zbuf(p, 0), (const bf16_t*)(p.ws + OFF_WML), 1024, 1024, E, shm); }
        { EpiY<1> E; E.gate = zbuf(p, 7); E.Y = zbuf(p, 1); run_gemm<GMT>(zbuf(p, 4), (const bf16_t*)(p.ws + OFF_WSC), 1024, 1024, E, shm); }
    } }
    if (((REP_MASK >> 9) & 1) && ((rm_ >> 9) & 1)) PH(9) { {
        { EpiY<0> E; E.gate = zbuf(p, 6); E.Y = zbuf(p, 1); run_gemm<GMT>(zbuf(p, 0), (const bf16_t*)(p.ws + OFF_WML), 1024, 1024, E, shm); }
        { EpiY<1> E; E.gate = zbuf(p, 7); E.Y = zbuf(p, 1); run_gemm<GMT>(zbuf(p, 4), (const bf16_t*)(p.ws + OFF_WSC), 1024, 1024, E, shm); }
    } }
    SYNC(9);
    PH(10) { {
        EpiResid E; E.xa = p.out; E.xb = p.out + (size_t)NPR * 1024; E.xo = p.out; E.gate = mod + 5 * 1024; E.scale = 1.0f; run_gemm<GMT>(zbuf(p, 1), (const bf16_t*)(p.ws + OFF_WO), 1024, 1024, E, shm);
    } }
    if (((REP_MASK >> 10) & 1) && ((rm_ >> 10) & 1)) PH(10) { {
        EpiResid E; E.xa = p.out; E.xb = p.out + (size_t)NPR * 1024; E.xo = p.out; E.gate = mod + 5 * 1024; E.scale = 1.0f; run_gemm<GMT>(zbuf(p, 1), (const bf16_t*)(p.ws + OFF_WO), 1024, 1024, E, shm);
    } }
    SYNC(10);
    PH(11) { row_phase<2>(p, shm); }
    if (((REP_MASK >> 11) & 1) && ((rm_ >> 11) & 1)) PH(11) { row_phase<2>(p, shm); }
    SYNC(11);
    PH(12) { { EpiSwiglu E; E.O = act; run_gemm<4>(zbuf(p, 7), (const bf16_t*)(p.ws + OFF_F2), 5632, 1024, E, shm); } }
    if (((REP_MASK >> 12) & 1) && ((rm_ >> 12) & 1)) PH(12) { { EpiSwiglu E; E.O = act; run_gemm<4>(zbuf(p, 7), (const bf16_t*)(p.ws + OFF_F2), 5632, 1024, E, shm); } }
    SYNC(12);
    PH(13) { { EpiResid E; E.xa = p.out; E.xb = p.out + (size_t)NPR * 1024; E.xo = p.out; E.gate = mod + 8 * 1024; E.scale = 0.5f; run_gemm<GMT>(act, (const bf16_t*)(p.ws + OFF_F2 + 11 * MiB), 1024, 2816, E, shm); } }
    if (((REP_MASK >> 13) & 1) && ((rm_ >> 13) & 1)) PH(13) { { EpiResid E; E.xa = p.out; E.xb = p.out + (size_t)NPR * 1024; E.xo = p.out; E.gate = mod + 8 * 1024; E.scale = 0.5f; run_gemm<GMT>(act, (const bf16_t*)(p.ws + OFF_F2 + 11 * MiB), 1024, 2816, E, shm); } }
    SYNC(13);
    PH(14) row_phase<3>(p, shm);
}

extern "C" void kernel_launch(void* const* d_in, const int* in_sizes, int n_in, void* d_out, int out_size, void* d_ws, size_t ws_size, hipStream_t stream) {
    static int grid_blocks = 0;
    if (!grid_blocks) {
        int dev = 0, cus = 0, per_cu = 0;
        hipGetDevice(&dev);
        hipDeviceGetAttribute(&cus, hipDeviceAttributeMultiprocessorCount, dev);
        hipFuncSetAttribute((const void*)mega, hipFuncAttributeMaxDynamicSharedMemorySize, LDS_BYTES);
        hipOccupancyMaxActiveBlocksPerMultiprocessor(&per_cu, mega, 512, LDS_BYTES);
        if (per_cu < 1) { fprintf(stderr, "occupancy query returned %d\n", per_cu); per_cu = 1; }
        grid_blocks = cus * per_cu;
    }
    Params p{};
    const float** f = (const float**)&p;
    for (int i = 0; i < 23; ++i) f[i] = (const float*)d_in[i];
    p.out = (float*)d_out; p.ws = (unsigned char*)d_ws; p.rep_mask = REP_MASK;
#if COOP
    (void)hipMemsetAsync((unsigned char*)d_ws + OFF_BAR, 0, XCD_BAR_WORDS * 4, stream);
    p.phase_lo = 0; p.phase_hi = 15;
    void* args[] = {&p};
    hipError_t e = hipLaunchCooperativeKernel((void*)mega, dim3(grid_blocks), dim3(512), args, LDS_BYTES, stream);
    if (e != hipSuccess) fprintf(stderr, "cooperative launch failed: %s (grid %d)\n", hipGetErrorString(e), grid_blocks);
#else
    for (int ph = 0; ph < 15; ++ph) { p.phase_lo = ph; p.phase_hi = ph + 1; hipLaunchKernelGGL(mega, dim3(grid_blocks), dim3(512), LDS_BYTES, stream, p); }
#endif
}
```
